# Optimizing an MI355X kernel written in HIP

```python
import math
import jax, jax.numpy as jnp
from jax import lax
import numpy as np

D_MODEL = 2048
BATCH = 2
SEQ = 4096
DEPTH = 1
DEC_BATCH = 8
DEC_SEQ = 1
PAST_LEN = 16384
PAGE_SIZE = 128

MIX_WIDTH = D_MODEL
ATTN_WIDTH = MIX_WIDTH // 2
N_ATTN_HEADS = 8
DV = ATTN_WIDTH // N_ATTN_HEADS
DK = DV // 2
D_INNER = MIX_WIDTH - ATTN_WIDTH
SSM_HEADDIM = 64
N_SSM_HEADS = D_INNER // SSM_HEADDIM
N_GROUPS = 2
HEADS_PER_GROUP = N_SSM_HEADS // N_GROUPS
D_STATE = 128
CONV_W = 4
CONV_DIM = D_INNER + 2 * N_GROUPS * D_STATE
CHUNK = 128
Q_BLOCK = 128
D_FF = 4 * D_MODEL
PLE_DIM = 256
D_PROJ = 3 * ATTN_WIDTH + D_INNER + CONV_DIM + N_SSM_HEADS
NORM_EPS = 1e-6
SUBLN_EPS = 1e-5

kernel_name = "hymba_diffattn_ssd_step"


def _rmsnorm(x, g, eps=NORM_EPS):
    xf = x.astype(jnp.float32)
    y = xf * lax.rsqrt(jnp.mean(xf * xf, axis=-1, keepdims=True) + eps)
    return (y * g.astype(jnp.float32)).astype(x.dtype)


def _alibi_slopes():
    return 2.0 ** (-8.0 * jnp.arange(1, N_ATTN_HEADS + 1, dtype=jnp.float32) / N_ATTN_HEADS)


def _split_proj(u, w_in):
    proj = u @ w_in
    cuts = np.cumsum([ATTN_WIDTH, ATTN_WIDTH, ATTN_WIDTH, D_INNER, CONV_DIM]).tolist()
    q, k, v, z, xbc, dt = jnp.split(proj, cuts, axis=-1)
    lead = u.shape[:-1]
    q = q.reshape(*lead, N_ATTN_HEADS, 2, DK)
    k = k.reshape(*lead, N_ATTN_HEADS, 2, DK)
    v = v.reshape(*lead, N_ATTN_HEADS, DV)
    return q, k, v, z, xbc, dt


def _diff_weights(s, lam):
    p = jax.nn.softmax(s, axis=-1)
    return p[:, :, 0] - lam * p[:, :, 1]


def _prompt_diff_attn(q, k, v, lam):
    b, s = q.shape[:2]
    nb = s // Q_BLOCK
    scale = DK ** -0.5
    slopes = _alibi_slopes()
    kpos = jnp.arange(s)
    qb = jnp.moveaxis(q.reshape(b, nb, Q_BLOCK, N_ATTN_HEADS, 2, DK), 1, 0)
    starts = jnp.arange(nb) * Q_BLOCK

    def one_block(args):
        qblk, st = args
        sc = jnp.einsum('bqhcd,bkhcd->bhcqk', qblk, k).astype(jnp.float32) * scale
        dist = ((st + jnp.arange(Q_BLOCK))[:, None] - kpos[None, :]).astype(jnp.float32)
        bias = jnp.where(dist[None] >= 0, -slopes[:, None, None] * dist[None], -jnp.inf)
        w = _diff_weights(sc + bias[None, :, None], lam)
        return jnp.einsum('bhqk,bkhd->bqhd', w.astype(v.dtype), v)

    o = lax.map(one_block, (qb, starts))
    return jnp.moveaxis(o, 0, 1).reshape(b, s, N_ATTN_HEADS, DV)


def _sample_diff_attn(q, k_new, v_new, k_past, v_past, lam):
    t = q.shape[1]
    p = k_past.shape[1]
    scale = DK ** -0.5
    slopes = _alibi_slopes()
    dist_p = ((p + jnp.arange(t))[:, None] - jnp.arange(p)[None, :]).astype(jnp.float32)
    bias_p = -slopes[:, None, None] * dist_p[None]
    dist_n = (jnp.arange(t)[:, None] - jnp.arange(t)[None, :]).astype(jnp.float32)
    bias_n = jnp.where(dist_n[None] >= 0, -slopes[:, None, None] * dist_n[None], -jnp.inf)
    s_p = jnp.einsum('bqhcd,bkhcd->bhcqk', q, k_past).astype(jnp.float32) * scale + bias_p[None, :, None]
    s_n = jnp.einsum('bqhcd,bkhcd->bhcqk', q, k_new).astype(jnp.float32) * scale + bias_n[None, :, None]
    w = _diff_weights(jnp.concatenate([s_p, s_n], axis=-1), lam).astype(v_new.dtype)
    return (jnp.einsum('bhqk,bkhd->bqhd', w[..., :p], v_past)
            + jnp.einsum('bhqk,bkhd->bqhd', w[..., p:], v_new))


def _attn_out(o, w_sub, lam_init):
    o = _rmsnorm(o, w_sub, SUBLN_EPS) * (1.0 - lam_init)
    return o.reshape(*o.shape[:-2], ATTN_WIDTH)


def _causal_conv(xpad, w, b):
    t = xpad.shape[1] - (CONV_W - 1)
    out = b + sum(xpad[:, j:j + t] * w[j] for j in range(CONV_W))
    return jax.nn.silu(out)


def _ssm_inputs(xbc_act, dt_raw, dt_bias, a_log):
    lead = xbc_act.shape[:-1]
    xs, bm, cm = jnp.split(xbc_act, [D_INNER, D_INNER + N_GROUPS * D_STATE], axis=-1)
    xs = xs.reshape(*lead, N_SSM_HEADS, SSM_HEADDIM).astype(jnp.float32)
    bm = bm.reshape(*lead, N_GROUPS, D_STATE).astype(jnp.float32)
    cm = cm.reshape(*lead, N_GROUPS, D_STATE).astype(jnp.float32)
    dt = jax.nn.softplus(dt_raw.astype(jnp.float32) + dt_bias.astype(jnp.float32))
    a = -jnp.exp(a_log.astype(jnp.float32))
    return xs, bm, cm, dt, a


def _ssd_chunked(xs, dt, a, bm, cm):
    b, s = xs.shape[:2]
    c = s // CHUNK
    xd = (xs * dt[..., None]).reshape(b, c, CHUNK, N_GROUPS, HEADS_PER_GROUP, SSM_HEADDIM)
    da = (dt * a).reshape(b, c, CHUNK, N_GROUPS, HEADS_PER_GROUP).transpose(0, 3, 4, 1, 2)
    a_cs = jnp.cumsum(da, axis=-1)
    bc = bm.reshape(b, c, CHUNK, N_GROUPS, D_STATE)
    cc = cm.reshape(b, c, CHUNK, N_GROUPS, D_STATE)
    causal = jnp.tril(jnp.ones((CHUNK, CHUNK), dtype=bool))
    seg = a_cs[..., :, None] - a_cs[..., None, :]
    lmat = jnp.exp(jnp.where(causal, seg, -jnp.inf))
    cb = jnp.einsum('bclgn,bcsgn->bcgls', cc, bc)
    y_diag = jnp.einsum('bcgls,bgjcls,bcsgjp->bclgjp', cb, lmat, xd)
    decay_states = jnp.exp(a_cs[..., -1:] - a_cs)
    states = jnp.einsum('bcsgn,bgjcs,bcsgjp->cbgjpn', bc, decay_states, xd)
    chunk_decay = jnp.exp(a_cs[..., -1]).transpose(3, 0, 1, 2)

    def step(carry, inp):
        st, dec = inp
        return carry * dec[..., None, None] + st, carry

    init = jnp.zeros((b, N_GROUPS, HEADS_PER_GROUP, SSM_HEADDIM, D_STATE), jnp.float32)
    final, states_in = lax.scan(step, init, (states, chunk_decay))
    y_off = jnp.einsum('bclgn,cbgjpn,bgjcl->bclgjp', cc, states_in, jnp.exp(a_cs))
    y = (y_diag + y_off).reshape(b, s, N_SSM_HEADS, SSM_HEADDIM)
    return y, final.reshape(b, N_SSM_HEADS, SSM_HEADDIM, D_STATE)


def _ssm_recurrent(xs, dt, a, bm, cm, state0):
    db, t = xs.shape[:2]
    xt = jnp.moveaxis(xs.reshape(db, t, N_GROUPS, HEADS_PER_GROUP, SSM_HEADDIM), 1, 0)
    dtt = jnp.moveaxis(dt.reshape(db, t, N_GROUPS, HEADS_PER_GROUP), 1, 0)
    bt = jnp.moveaxis(bm, 1, 0)
    ct = jnp.moveaxis(cm, 1, 0)
    a_gj = a.reshape(N_GROUPS, HEADS_PER_GROUP)

    def step(st, inp):
        x_, d_, b_, c_ = inp
        st = st * jnp.exp(d_ * a_gj)[..., None, None] + jnp.einsum('bgjp,bgn->bgjpn', x_ * d_[..., None], b_)
        return st, jnp.einsum('bgjpn,bgn->bgjp', st, c_)

    st0 = state0.astype(jnp.float32).reshape(db, N_GROUPS, HEADS_PER_GROUP, SSM_HEADDIM, D_STATE)
    final, ys = lax.scan(step, st0, (xt, dtt, bt, ct))
    y = jnp.moveaxis(ys, 0, 1).reshape(db, t, N_SSM_HEADS, SSM_HEADDIM)
    return y, final.reshape(db, N_SSM_HEADS, SSM_HEADDIM, D_STATE)


def _ssm_out(y, xs, d_skip, z, w_norm):
    lead = z.shape[:-1]
    y = y + d_skip.astype(jnp.float32)[:, None] * xs
    g = (y.reshape(*lead, D_INNER) * jax.nn.silu(z.astype(jnp.float32)))
    g = g.reshape(*lead, N_GROUPS, D_INNER // N_GROUPS)
    g = g * lax.rsqrt(jnp.mean(g * g, axis=-1, keepdims=True) + NORM_EPS)
    return (g.reshape(*lead, D_INNER) * w_norm.astype(jnp.float32)).astype(z.dtype)


def _channel_and_ple(h, mix, p_l, w_out, g_ffn, w_up, w_down, w_ple, w_ple_norm, w_ple_gate):
    h = h + mix @ w_out
    u = _rmsnorm(h, g_ffn)
    h = h + jnp.square(jax.nn.relu(u @ w_up)) @ w_down
    e = _rmsnorm(p_l @ w_ple, w_ple_norm) * jax.nn.sigmoid(h @ w_ple_gate)
    return h + e


def setup_inputs(seed: int = 0) -> dict:
    key = jax.random.key(seed)
    kit = iter(jax.random.split(key, 40))

    def nrm(shape, scale):
        return jax.random.normal(next(kit), shape, jnp.float32) * scale

    n_pages = PAST_LEN // PAGE_SIZE
    n_used = DEC_BATCH * n_pages
    n_pool = n_used + max(1, n_used // 4)
    perm = jax.random.permutation(next(kit), n_pool)
    page_table = perm[:n_used].reshape(DEC_BATCH, n_pages).astype(jnp.int32)
    dt0 = jnp.exp(jax.random.uniform(next(kit), (DEPTH, N_SSM_HEADS), jnp.float32,
                                     minval=math.log(1e-3), maxval=math.log(1e-1)))
    dt_bias = dt0 + jnp.log(-jnp.expm1(-dt0))
    a_log = jnp.log(jax.random.uniform(next(kit), (DEPTH, N_SSM_HEADS), jnp.float32, minval=1.0, maxval=16.0))
    return {
        "x_prompt": nrm((BATCH, SEQ, D_MODEL), 1.0),
        "x_sample": nrm((DEC_BATCH, DEC_SEQ, D_MODEL), 1.0),
        "p_prompt": nrm((DEPTH, BATCH, SEQ, PLE_DIM), 1.0),
        "p_sample": nrm((DEPTH, DEC_BATCH, DEC_SEQ, PLE_DIM), 1.0),
        "cache_k": nrm((DEPTH, n_pool, PAGE_SIZE, N_ATTN_HEADS, 2 * DK), 1.0),
        "cache_v": nrm((DEPTH, n_pool, PAGE_SIZE, N_ATTN_HEADS, DV), 1.0),
        "page_table": page_table,
        "state_ssm": nrm((DEPTH, DEC_BATCH, N_SSM_HEADS, SSM_HEADDIM, D_STATE), 0.5),
        "state_conv": nrm((DEPTH, DEC_BATCH, CONV_W - 1, CONV_DIM), 1.0),
        "g_mix": 1.0 + nrm((DEPTH, D_MODEL), 0.02),
        "w_in": nrm((DEPTH, D_MODEL, D_PROJ), D_MODEL ** -0.5),
        "lambda_q1": nrm((DEPTH, DK), 0.1),
        "lambda_k1": nrm((DEPTH, DK), 0.1),
        "lambda_q2": nrm((DEPTH, DK), 0.1),
        "lambda_k2": nrm((DEPTH, DK), 0.1),
        "w_subln": 1.0 + nrm((DEPTH, DV), 0.02),
        "conv_w": nrm((DEPTH, CONV_W, CONV_DIM), CONV_W ** -0.5),
        "conv_b": nrm((DEPTH, CONV_DIM), 0.01),
        "dt_bias": dt_bias,
        "a_log": a_log,
        "d_skip": 1.0 + nrm((DEPTH, N_SSM_HEADS), 0.01),
        "w_ssm_norm": 1.0 + nrm((DEPTH, D_INNER), 0.02),
        "w_out": nrm((DEPTH, MIX_WIDTH, D_MODEL), MIX_WIDTH ** -0.5),
        "g_ffn": 1.0 + nrm((DEPTH, D_MODEL), 0.02),
        "w_up": nrm((DEPTH, D_MODEL, D_FF), D_MODEL ** -0.5),
        "w_down": nrm((DEPTH, D_FF, D_MODEL), 0.5 * D_FF ** -0.5),
        "w_ple": nrm((DEPTH, PLE_DIM, D_MODEL), PLE_DIM ** -0.5),
        "w_ple_norm": 1.0 + nrm((DEPTH, D_MODEL), 0.02),
        "w_ple_gate": nrm((DEPTH, D_MODEL, D_MODEL), D_MODEL ** -0.5),
        "g_final": 1.0 + nrm((D_MODEL,), 0.02),
    }


def reference(x_prompt, x_sample, p_prompt, p_sample, cache_k, cache_v, page_table, state_ssm, state_conv,
              g_mix, w_in, lambda_q1, lambda_k1, lambda_q2, lambda_k2, w_subln, conv_w, conv_b, dt_bias, a_log,
              d_skip, w_ssm_norm, w_out, g_ffn, w_up, w_down, w_ple, w_ple_norm, w_ple_gate, g_final):
    db = x_sample.shape[0]
    past = page_table.shape[1] * cache_k.shape[2]
    hp, hs = x_prompt, x_sample
    kp_l, vp_l, sp_l, cp_l, ks_l, vs_l, ss_l, cs_l = [], [], [], [], [], [], [], []
    for i in range(DEPTH):
        lam_init = 0.8 - 0.6 * math.exp(-0.3 * i)
        lam = (jnp.exp(jnp.sum(lambda_q1[i].astype(jnp.float32) * lambda_k1[i].astype(jnp.float32)))
               - jnp.exp(jnp.sum(lambda_q2[i].astype(jnp.float32) * lambda_k2[i].astype(jnp.float32)))
               + lam_init)

        u = _rmsnorm(hp, g_mix[i])
        q, k, v, z, xbc, dt = _split_proj(u, w_in[i])
        o_attn = _attn_out(_prompt_diff_attn(q, k, v, lam), w_subln[i], lam_init)
        xpad = jnp.pad(xbc, ((0, 0), (CONV_W - 1, 0), (0, 0)))
        xs, bm, cm, dtv, a = _ssm_inputs(_causal_conv(xpad, conv_w[i], conv_b[i]), dt, dt_bias[i], a_log[i])
        y, st = _ssd_chunked(xs, dtv, a, bm, cm)
        o_ssm = _ssm_out(y, xs, d_skip[i], z, w_ssm_norm[i])
        mix = jnp.concatenate([o_attn, o_ssm.astype(o_attn.dtype)], axis=-1)
        hp = _channel_and_ple(hp, mix, p_prompt[i], w_out[i], g_ffn[i], w_up[i], w_down[i],
                              w_ple[i], w_ple_norm[i], w_ple_gate[i])
        kp_l.append(k.reshape(*k.shape[:-2], 2 * DK))
        vp_l.append(v)
        sp_l.append(st)
        cp_l.append(xpad[:, -(CONV_W - 1):])

        u = _rmsnorm(hs, g_mix[i])
        q, k, v, z, xbc, dt = _split_proj(u, w_in[i])
        k_past = cache_k[i][page_table].reshape(db, past, N_ATTN_HEADS, 2, DK)
        v_past = cache_v[i][page_table].reshape(db, past, N_ATTN_HEADS, DV)
        o_attn = _attn_out(_sample_diff_attn(q, k, v, k_past, v_past, lam), w_subln[i], lam_init)
        xcat = jnp.concatenate([state_conv[i].astype(xbc.dtype), xbc], axis=1)
        xs, bm, cm, dtv, a = _ssm_inputs(_causal_conv(xcat, conv_w[i], conv_b[i]), dt, dt_bias[i], a_log[i])
        y, st = _ssm_recurrent(xs, dtv, a, bm, cm, state_ssm[i])
        o_ssm = _ssm_out(y, xs, d_skip[i], z, w_ssm_norm[i])
        mix = jnp.concatenate([o_attn, o_ssm.astype(o_attn.dtype)], axis=-1)
        hs = _channel_and_ple(hs, mix, p_sample[i], w_out[i], g_ffn[i], w_up[i], w_down[i],
                              w_ple[i], w_ple_norm[i], w_ple_gate[i])
        ks_l.append(k.reshape(*k.shape[:-2], 2 * DK))
        vs_l.append(v)
        ss_l.append(st)
        cs_l.append(xcat[:, -(CONV_W - 1):])

    y_prompt = _rmsnorm(hp, g_final)
    y_sample = _rmsnorm(hs, g_final)
    k_prompt = jnp.stack(kp_l)
    v_prompt = jnp.stack(vp_l)
    ssm_prompt = jnp.stack(sp_l)
    conv_prompt = jnp.stack(cp_l)
    k_sample = jnp.stack(ks_l)
    v_sample = jnp.stack(vs_l)
    ssm_sample = jnp.stack(ss_l)
    conv_sample = jnp.stack(cs_l)
    return (y_prompt, y_sample, k_prompt, v_prompt, ssm_prompt, conv_prompt, k_sample, v_sample, ssm_sample, conv_sample)
```

```cpp
#include <hip/hip_runtime.h>
#include <cstdio>
#include <cstdint>

#ifndef MK_SPLIT
#define MK_SPLIT 0
#endif

constexpr int MROWS = 8192, DMODEL = 2048, SEQ = 4096;
constexpr int NPROJ = 5648, NPAD = 5888;
constexpr int DFF = 8192, PLE = 256;
constexpr int C_Q = 0, C_K = 1024, C_V = 2048, C_Z = 3072, C_X = 4096, C_B = 5120, C_C = 5376, C_DT = 5632;
constexpr int XBC = 1536;
constexpr int DB = 8, PAST = 16384, PAGE = 128, NPAGES = 128;
constexpr float NORM_EPS = 1e-6f, SUBLN_EPS = 1e-5f;
constexpr float LOG2E = 1.4426950408889634f;
constexpr float QSCALE = 0.125f * LOG2E;
constexpr float LAM_INIT = 0.2f;

namespace pg8 {
#define PG8_LAS __attribute__((address_space(3)))
typedef unsigned short bf16_t;
typedef short bf16x8 __attribute__((ext_vector_type(8)));
typedef float f32x4 __attribute__((ext_vector_type(4)));
typedef unsigned u32x4 __attribute__((ext_vector_type(4)));
constexpr int BM = 256, BK = 64, HALF = 128, HTB = HALF * BK * 2  , STAGE_BYTES = 8 * HTB, NXCD = 8, WGM = 8;

__host__ __device__ __forceinline__ int lds_byte(int r, int c) { const int st = (r >> 4) * 2 + (c >> 5), rr = r & 15, cc = c & 31, ob = rr * 64 + cc * 2; return st * 1024 + (ob ^ (((ob >> 9) & 1) << 5)); }
__host__ __device__ __forceinline__ void stage_rc(int b, int& R, int& C) { const int st = b / 1024, sb = b % 1024, swz = sb ^ (((sb >> 9) & 1) << 5); R = (st >> 1) * 16 + swz / 64; C = (st & 1) * 32 + (swz % 64) / 2; }
__host__ __device__ __forceinline__ int perm32(int rho) { const int n = rho >> 4, i = rho & 15; return 8 * (i >> 2) + 4 * n + (i & 3); }

struct Unit { int pm, pn; };
struct Gemm { const bf16_t* A; const bf16_t* Bt; int M, N, K; };

struct StaticOrder {
    int nM, nN, nwg, G, c;
    __host__ __device__ void init(int M, int N, int G_, int c_) { nM = M / BM; nN = N / BM; nwg = nM * nN; G = G_; c = c_; }
    __host__ __device__ bool next(int i, Unit& u) const {
        const long L = (long)i * G + c; if (L >= nwg) return false;
        int wgid = (int)L; { const int q = nwg / NXCD, r = nwg % NXCD, xcd = wgid % NXCD, off = wgid / NXCD; wgid = (xcd < r ? xcd * (q + 1) : r * (q + 1) + (xcd - r) * q) + off; }
        const int nig = WGM * nN, gid = wgid / nig, fm = gid * WGM, gsz = (nM - fm) < WGM ? (nM - fm) : WGM;
        u.pm = fm + ((wgid % nig) % gsz); u.pn = (wgid % nig) / gsz; return true;
    }
    __device__ __forceinline__ void a_ready(const Unit&) const {}
    __device__ __forceinline__ void done(const Unit&) const {}
};

__device__ __forceinline__ unsigned cvt_pk_bf16(float lo, float hi) { unsigned r; asm volatile("v_cvt_pk_bf16_f32 %0, %1, %2" : "=v"(r) : "v"(lo), "v"(hi)); return r; }
typedef float f32x2 __attribute__((ext_vector_type(2)));
typedef unsigned u32x2 __attribute__((ext_vector_type(2)));
__device__ __forceinline__ u32x4 pack8(f32x4 a, f32x4 b) { u32x4 w; w.x = cvt_pk_bf16(a[0], a[1]); w.y = cvt_pk_bf16(a[2], a[3]); w.z = cvt_pk_bf16(b[0], b[1]); w.w = cvt_pk_bf16(b[2], b[3]); return w; }
__device__ __forceinline__ float sumsq8(f32x4 a, f32x4 b) { return (a[0] * a[0] + a[1] * a[1]) + (a[2] * a[2] + a[3] * a[3]) + (b[0] * b[0] + b[1] * b[1]) + (b[2] * b[2] + b[3] * b[3]); }

struct EpiProj {
    static constexpr bool PERM = true, AFTER_DRAIN = false;
    bf16_t* proj; float* kout; float* vout; float* convout; float* dt;
    __device__ __forceinline__ void operator()(const f32x4 (&acc)[2][2][4][2], const Unit& u, int wr, int wc, int fr, int fq) const {
        const int pn = u.pn, row0 = u.pm * BM + wr * 64 + fr, colw = wc * 32 + 8 * fq;
        if (pn < 22) {
            const float sc = pn < 4 ? QSCALE : 1.f;
#pragma unroll
            for (int ai = 0; ai < 2; ++ai)
#pragma unroll
                for (int m = 0; m < 4; ++m) { const int row = row0 + ai * HALF + m * 16;
#pragma unroll
                    for (int bj = 0; bj < 2; ++bj) { const int col = pn * BM + bj * HALF + colw;
                        const f32x4 v0 = acc[ai][bj][m][0] * sc, v1 = acc[ai][bj][m][1] * sc;
                        *(u32x4*)(proj + (size_t)row * NPAD + col) = pack8(v0, v1);
                        if (pn >= 4 && pn < 8) { float* o = kout + (size_t)row * 1024 + (col - C_K); *(f32x4*)o = v0; *(f32x4*)(o + 4) = v1; }
                        else if (pn >= 8 && pn < 12) { float* o = vout + (size_t)row * 1024 + (col - C_V); *(f32x4*)o = v0; *(f32x4*)(o + 4) = v1; }
                        else if (pn >= 16) { const int t = row & (SEQ - 1); if (t >= SEQ - 3) { float* o = convout + ((size_t)(row >> 12) * 3 + (t - (SEQ - 3))) * XBC + (col - C_X); *(f32x4*)o = v0; *(f32x4*)(o + 4) = v1; } }
                    } }
        } else {
            if (wc == 0 && fq < 2) {
#pragma unroll
                for (int ai = 0; ai < 2; ++ai)
#pragma unroll
                    for (int m = 0; m < 4; ++m) { const int row = row0 + ai * HALF + m * 16; float* o = dt + (size_t)row * 16 + 8 * fq; *(f32x4*)o = acc[ai][0][m][0]; *(f32x4*)(o + 4) = acc[ai][0][m][1]; }
            }
        }
    }
};
struct EpiOut {
    static constexpr bool PERM = true, AFTER_DRAIN = false;
    const float* xres; float* h1; bf16_t* a2; const float* g; float* ss;
    __device__ __forceinline__ void operator()(const f32x4 (&acc)[2][2][4][2], const Unit& u, int wr, int wc, int fr, int fq) const {
        const int row0 = u.pm * BM + wr * 64 + fr, colw = u.pn * BM + wc * 32 + 8 * fq;
#pragma unroll
        for (int ai = 0; ai < 2; ++ai)
#pragma unroll
            for (int m = 0; m < 4; ++m) { const int row = row0 + ai * HALF + m * 16; float s = 0.f;
#pragma unroll
                for (int bj = 0; bj < 2; ++bj) { const int col = colw + bj * HALF; const size_t off = (size_t)row * DMODEL + col;
                    const f32x4 h0 = *(const f32x4*)(xres + off) + acc[ai][bj][m][0], h1v = *(const f32x4*)(xres + off + 4) + acc[ai][bj][m][1];
                    *(f32x4*)(h1 + off) = h0; *(f32x4*)(h1 + off + 4) = h1v;
                    const f32x4 g0 = *(const f32x4*)(g + col), g1 = *(const f32x4*)(g + col + 4);
                    *(u32x4*)(a2 + off) = pack8(h0 * g0, h1v * g1);
                    s += sumsq8(h0, h1v); }
                s += __shfl_xor(s, 16); s += __shfl_xor(s, 32);
                if (fq == 0) atomicAdd(ss + row, s); }
    }
};
struct EpiUp {
    static constexpr bool PERM = true, AFTER_DRAIN = false;
    bf16_t* hb; const float* ss;
    __device__ __forceinline__ void operator()(const f32x4 (&acc)[2][2][4][2], const Unit& u, int wr, int wc, int fr, int fq) const {
        const int row0 = u.pm * BM + wr * 64 + fr, colw = u.pn * BM + wc * 32 + 8 * fq;
#pragma unroll
        for (int ai = 0; ai < 2; ++ai)
#pragma unroll
            for (int m = 0; m < 4; ++m) { const int row = row0 + ai * HALF + m * 16; const float rstd = rsqrtf(ss[row] * (1.f / DMODEL) + NORM_EPS);
#pragma unroll
                for (int bj = 0; bj < 2; ++bj) { const int col = colw + bj * HALF;
                    f32x4 v0 = acc[ai][bj][m][0] * rstd, v1 = acc[ai][bj][m][1] * rstd;
#pragma unroll
                    for (int e = 0; e < 4; ++e) { const float a = fmaxf(v0[e], 0.f), b = fmaxf(v1[e], 0.f); v0[e] = a * a; v1[e] = b * b; }
                    *(u32x4*)(hb + (size_t)row * DFF + col) = pack8(v0, v1); } }
    }
};
struct EpiDown {
    static constexpr bool PERM = true, AFTER_DRAIN = false;
    float* h; bf16_t* hb16;
    __device__ __forceinline__ void operator()(const f32x4 (&acc)[2][2][4][2], const Unit& u, int wr, int wc, int fr, int fq) const {
        const int row0 = u.pm * BM + wr * 64 + fr, colw = u.pn * BM + wc * 32 + 8 * fq;
#pragma unroll
        for (int ai = 0; ai < 2; ++ai)
#pragma unroll
            for (int m = 0; m < 4; ++m) { const int row = row0 + ai * HALF + m * 16;
#pragma unroll
                for (int bj = 0; bj < 2; ++bj) { const size_t off = (size_t)row * DMODEL + colw + bj * HALF;
                    const f32x4 h0 = *(const f32x4*)(h + off) + acc[ai][bj][m][0], h1v = *(const f32x4*)(h + off + 4) + acc[ai][bj][m][1];
                    *(f32x4*)(h + off) = h0; *(f32x4*)(h + off + 4) = h1v; *(u32x4*)(hb16 + off) = pack8(h0, h1v); } }
    }
};
struct EpiPle {
    static constexpr bool PERM = true, AFTER_DRAIN = false;
    float* e0; float* sse;
    __device__ __forceinline__ void operator()(const f32x4 (&acc)[2][2][4][2], const Unit& u, int wr, int wc, int fr, int fq) const {
        const int row0 = u.pm * BM + wr * 64 + fr, colw = u.pn * BM + wc * 32 + 8 * fq;
#pragma unroll
        for (int ai = 0; ai < 2; ++ai)
#pragma unroll
            for (int m = 0; m < 4; ++m) { const int row = row0 + ai * HALF + m * 16; float s = 0.f;
#pragma unroll
                for (int bj = 0; bj < 2; ++bj) { const size_t off = (size_t)row * DMODEL + colw + bj * HALF;
                    *(f32x4*)(e0 + off) = acc[ai][bj][m][0]; *(f32x4*)(e0 + off + 4) = acc[ai][bj][m][1]; s += sumsq8(acc[ai][bj][m][0], acc[ai][bj][m][1]); }
                s += __shfl_xor(s, 16); s += __shfl_xor(s, 32);
                if (fq == 0) atomicAdd(sse + row, s); }
    }
};
struct EpiGate {
    static constexpr bool PERM = true, AFTER_DRAIN = false;
    const float* h2; const float* e0; const float* sse; const float* wn; float* out; float* ss3;
    __device__ __forceinline__ void operator()(const f32x4 (&acc)[2][2][4][2], const Unit& u, int wr, int wc, int fr, int fq) const {
        const int row0 = u.pm * BM + wr * 64 + fr, colw = u.pn * BM + wc * 32 + 8 * fq;
#pragma unroll
        for (int ai = 0; ai < 2; ++ai)
#pragma unroll
            for (int m = 0; m < 4; ++m) { const int row = row0 + ai * HALF + m * 16; const float rstde = rsqrtf(sse[row] * (1.f / DMODEL) + NORM_EPS); float s = 0.f;
#pragma unroll
                for (int bj = 0; bj < 2; ++bj) { const int col = colw + bj * HALF; const size_t off = (size_t)row * DMODEL + col;
#pragma unroll
                    for (int n = 0; n < 2; ++n) { const f32x4 a = acc[ai][bj][m][n], hv = *(const f32x4*)(h2 + off + 4 * n), ev = *(const f32x4*)(e0 + off + 4 * n), wv = *(const f32x4*)(wn + col + 4 * n); f32x4 o;
#pragma unroll
                        for (int e = 0; e < 4; ++e) { const float sg = 1.f / (1.f + __expf(-a[e])); o[e] = hv[e] + ev[e] * rstde * wv[e] * sg; s += o[e] * o[e]; }
                        *(f32x4*)(out + off + 4 * n) = o; } }
                s += __shfl_xor(s, 16); s += __shfl_xor(s, 32);
                if (fq == 0) atomicAdd(ss3 + row, s); }
    }
};

template <class Epi, class Sched, bool ALIGN_EPI = false, bool SP2 = false>
__device__ __forceinline__ void gemm_phase(PG8_LAS unsigned char* lds, const Gemm g, const Sched& S, const Epi& E) {
    const int tid = threadIdx.x, wid = __builtin_amdgcn_readfirstlane(tid >> 6), lane = tid & 63, wr = wid >> 2, wc = wid & 3, fr = lane & 15, fq = lane >> 4;
    const int K = g.K, nt = K / BK;
    unsigned voffA[2], voffB[2];
#pragma unroll
    for (int i = 0; i < 2; ++i) { int R, C; stage_rc(tid * 16 + i * 8192, R, C); const int Rb = Epi::PERM ? ((R & ~31) + perm32(R & 31)) : R;
        voffA[i] = (unsigned)(R * K + C) * 2u; voffB[i] = (unsigned)(Rb * K + C) * 2u; }
    const size_t kstep = (size_t)(BK * 2);
    const size_t hstep = (size_t)HALF * K * 2;
    const size_t tstep = 2 * hstep;
    const unsigned ldsw = (unsigned)wid * 1024u;
    const int aoff = lds_byte(wr * 64 + fr, fq * 8), boff = lds_byte(wc * 32 + fr, fq * 8);
#define PG8_SA(b, h) (((b) * 2 + (h)) * HTB)
#define PG8_SB(b, h) ((4 + (b) * 2 + (h)) * HTB)
#define PG8_STAGE(bufoff, gbase, voff) do { _Pragma("unroll") for (int _i = 0; _i < 2; ++_i) \
        __builtin_amdgcn_global_load_lds((const unsigned*)((const char*)(gbase) + (voff)[_i]), (PG8_LAS unsigned*)(lds + (bufoff) + ldsw + _i * 8192), 16, 0, 0); } while (0)
#define PG8_LDA(dst, b, h) do { _Pragma("unroll") for (int m = 0; m < 4; ++m) _Pragma("unroll") for (int k = 0; k < 2; ++k) dst[m][k] = *(const PG8_LAS bf16x8*)(lds + PG8_SA(b, h) + aoff + m * 2048 + k * 1024); } while (0)
#define PG8_LDB(dst, b, h) do { _Pragma("unroll") for (int n = 0; n < 2; ++n) _Pragma("unroll") for (int k = 0; k < 2; ++k) dst[n][k] = *(const PG8_LAS bf16x8*)(lds + PG8_SB(b, h) + boff + n * 2048 + k * 1024); } while (0)
#define PG8_MMA(ai, bj, At, Bt) do { __builtin_amdgcn_s_setprio(1); _Pragma("unroll") for (int m = 0; m < 4; ++m) _Pragma("unroll") for (int n = 0; n < 2; ++n) _Pragma("unroll") for (int k = 0; k < 2; ++k) \
        acc[ai][bj][m][n] = __builtin_amdgcn_mfma_f32_16x16x32_bf16(Bt[n][k], At[m][k], acc[ai][bj][m][n], 0, 0, 0); __builtin_amdgcn_s_setprio(0); } while (0)
#define PG8_WAIT_V(n) asm volatile("s_waitcnt vmcnt(" #n ")" ::: "memory")
#define PG8_WAIT_L(n) asm volatile("s_waitcnt lgkmcnt(" #n ")" ::: "memory")
#define PG8_BAR __builtin_amdgcn_s_barrier()
#define PG8_SCHED __builtin_amdgcn_sched_barrier(0)
    Unit cur, nxt; int ui = 0;
    if (!S.next(0, cur)) return;
    f32x4 acc[2][2][4][2];
#pragma unroll
    for (int a = 0; a < 2; ++a)
#pragma unroll
        for (int b = 0; b < 2; ++b)
#pragma unroll
            for (int m = 0; m < 4; ++m)
#pragma unroll
                for (int n = 0; n < 2; ++n) acc[a][b][m][n] = (f32x4){0.f, 0.f, 0.f, 0.f};
    bf16x8 At[4][2], B0[2][2], B1[2][2];
    const char* cA = (const char*)g.A + (size_t)cur.pm * tstep; const char* cB = (const char*)g.Bt + (size_t)cur.pn * tstep;
    S.a_ready(cur);
    if constexpr (SP2) {
        PG8_STAGE(PG8_SB(0, 0), cB, voffB); PG8_STAGE(PG8_SB(0, 1), cB + hstep, voffB); PG8_STAGE(PG8_SA(0, 0), cA, voffA); PG8_STAGE(PG8_SA(0, 1), cA + hstep, voffA);
        if (wr == 1) PG8_BAR;
        PG8_WAIT_V(2); PG8_BAR;
        PG8_STAGE(PG8_SB(1, 0), cB + kstep, voffB); PG8_STAGE(PG8_SA(1, 0), cA + kstep, voffA); PG8_STAGE(PG8_SB(1, 1), cB + hstep + kstep, voffB);
        PG8_WAIT_V(6); PG8_BAR;
    } else {
        PG8_STAGE(PG8_SB(0, 0), cB, voffB); PG8_STAGE(PG8_SA(0, 0), cA, voffA); PG8_STAGE(PG8_SB(0, 1), cB + hstep, voffB); PG8_STAGE(PG8_SA(0, 1), cA + hstep, voffA);
        if (wr == 1) PG8_BAR;
        PG8_WAIT_V(4); PG8_BAR;
        PG8_STAGE(PG8_SB(1, 0), cB + kstep, voffB); PG8_STAGE(PG8_SA(1, 0), cA + kstep, voffA); PG8_STAGE(PG8_SB(1, 1), cB + hstep + kstep, voffB);
        PG8_WAIT_V(6); PG8_BAR;
    }
    for (;;) {
        const bool has_next = S.next(ui + 1, nxt);
        const char* nA = has_next ? (const char*)g.A + (size_t)nxt.pm * tstep : cA; const char* nB = has_next ? (const char*)g.Bt + (size_t)nxt.pn * tstep : cB;
        _Pragma("nounroll") for (int t = 0; t < nt; t += 2) {
            const bool last = (t == nt - 2);
            const char* a1 = cA + (size_t)(t + 1) * kstep;
            const char* a2 = last ? nA : cA + (size_t)(t + 2) * kstep; const char* b2 = last ? nB : cB + (size_t)(t + 2) * kstep;
            const char* a3 = a2 + kstep; const char* b3 = b2 + kstep;
            if (last && has_next) S.a_ready(nxt);
            if constexpr (SP2) {
            PG8_LDB(B0, 0, 0); PG8_LDB(B1, 0, 1); PG8_SCHED; PG8_LDA(At, 0, 0); PG8_STAGE(PG8_SA(1, 1), a1 + hstep, voffA);
            PG8_WAIT_V(8); PG8_WAIT_L(0); PG8_BAR; PG8_MMA(0, 0, At, B0); PG8_MMA(0, 1, At, B1); PG8_BAR; PG8_SCHED;
            PG8_LDA(At, 0, 1); PG8_STAGE(PG8_SB(0, 0), b2, voffB); PG8_STAGE(PG8_SB(0, 1), b2 + hstep, voffB); PG8_STAGE(PG8_SA(0, 0), a2, voffA);
            PG8_WAIT_V(8); PG8_WAIT_L(0); PG8_BAR; PG8_MMA(1, 0, At, B0); PG8_MMA(1, 1, At, B1); PG8_BAR; PG8_SCHED;
            PG8_LDB(B0, 1, 0); PG8_LDB(B1, 1, 1); PG8_SCHED; PG8_LDA(At, 1, 0); PG8_STAGE(PG8_SA(0, 1), a2 + hstep, voffA);
            PG8_WAIT_V(8); PG8_WAIT_L(0); PG8_BAR; PG8_MMA(0, 0, At, B0); PG8_MMA(0, 1, At, B1); PG8_BAR; PG8_SCHED;
            PG8_LDA(At, 1, 1); PG8_STAGE(PG8_SB(1, 0), b3, voffB); PG8_STAGE(PG8_SB(1, 1), b3 + hstep, voffB); PG8_STAGE(PG8_SA(1, 0), a3, voffA);
            PG8_WAIT_V(8); PG8_WAIT_L(0); PG8_BAR; PG8_MMA(1, 0, At, B0); PG8_MMA(1, 1, At, B1); PG8_BAR; PG8_SCHED;
            } else {
            PG8_LDB(B0, 0, 0); PG8_SCHED; PG8_LDA(At, 0, 0); PG8_STAGE(PG8_SA(1, 1), a1 + hstep, voffA);
            PG8_WAIT_L(8); PG8_BAR; PG8_WAIT_L(0); PG8_MMA(0, 0, At, B0); PG8_BAR; PG8_SCHED;
            PG8_LDB(B1, 0, 1); PG8_STAGE(PG8_SB(0, 0), b2, voffB);
            PG8_BAR; PG8_WAIT_L(0); PG8_MMA(0, 1, At, B1); PG8_BAR;
            PG8_LDA(At, 0, 1); PG8_STAGE(PG8_SA(0, 0), a2, voffA);
            PG8_BAR; PG8_WAIT_L(0); PG8_MMA(1, 0, At, B0); PG8_BAR; PG8_SCHED;
            PG8_STAGE(PG8_SB(0, 1), b2 + hstep, voffB);
            PG8_WAIT_V(6); PG8_BAR; PG8_MMA(1, 1, At, B1); PG8_BAR;
            PG8_LDB(B0, 1, 0); PG8_SCHED; PG8_LDA(At, 1, 0); PG8_STAGE(PG8_SA(0, 1), a2 + hstep, voffA);
            PG8_WAIT_L(8); PG8_BAR; PG8_WAIT_L(0); PG8_MMA(0, 0, At, B0); PG8_BAR; PG8_SCHED;
            PG8_LDB(B1, 1, 1); PG8_STAGE(PG8_SB(1, 0), b3, voffB);
            PG8_BAR; PG8_WAIT_L(0); PG8_MMA(0, 1, At, B1); PG8_BAR;
            PG8_LDA(At, 1, 1); PG8_STAGE(PG8_SA(1, 0), a3, voffA);
            PG8_BAR; PG8_WAIT_L(0); PG8_MMA(1, 0, At, B0); PG8_BAR; PG8_SCHED;
            PG8_STAGE(PG8_SB(1, 1), b3 + hstep, voffB);
            PG8_WAIT_V(6); PG8_BAR; PG8_MMA(1, 1, At, B1); PG8_BAR;
            }
        }
        if constexpr (ALIGN_EPI) { if (wr == 0) PG8_BAR; }
        if constexpr (!Epi::AFTER_DRAIN) { E(acc, cur, wr, wc, fr, fq); S.done(cur); }
        if (!has_next) break;
#pragma unroll
        for (int a = 0; a < 2; ++a)
#pragma unroll
            for (int b = 0; b < 2; ++b)
#pragma unroll
                for (int m = 0; m < 4; ++m)
#pragma unroll
                    for (int n = 0; n < 2; ++n) acc[a][b][m][n] = (f32x4){0.f, 0.f, 0.f, 0.f};
        cur = nxt; cA = nA; cB = nB; ++ui;
        if constexpr (ALIGN_EPI) { if (wr == 1) PG8_BAR; }
    }
    PG8_WAIT_V(0);
    if constexpr (!ALIGN_EPI) { if (wr == 0) PG8_BAR; }
    PG8_BAR;
    if constexpr (Epi::AFTER_DRAIN) { E.fused(acc, cur, wr, wc, fr, fq, lds, wid, lane); S.done(cur); }
#undef PG8_SA
#undef PG8_SB
#undef PG8_STAGE
#undef PG8_LDA
#undef PG8_LDB
#undef PG8_MMA
#undef PG8_WAIT_V
#undef PG8_WAIT_L
#undef PG8_BAR
#undef PG8_SCHED
}
}
#define GAS __attribute__((address_space(1)))
#define LAS __attribute__((address_space(3)))
typedef unsigned short bf16;
typedef unsigned v4u __attribute__((ext_vector_type(4)));
typedef float f32x4 __attribute__((ext_vector_type(4)));
typedef short bf16x8 __attribute__((ext_vector_type(8)));
typedef GAS unsigned gu32;
typedef GAS unsigned long long gu64;
#define RLX_AGENT __ATOMIC_RELAXED, __HIP_MEMORY_SCOPE_AGENT
#define LDS_WAIT() asm volatile("s_waitcnt lgkmcnt(0)" ::: "memory")
#define VM_WAIT() asm volatile("s_waitcnt vmcnt(0)" ::: "memory")
__device__ __forceinline__ unsigned long long rt() { return __builtin_amdgcn_s_memrealtime(); }
__device__ __forceinline__ unsigned f2bf(float f) { unsigned u = __builtin_bit_cast(unsigned, f); return (u + 0x7fffu + ((u >> 16) & 1u)) >> 16; }
__device__ __forceinline__ unsigned pk2(float lo, float hi) { return f2bf(lo) | (f2bf(hi) << 16); }

#define XB_TMO      128
#define XB_XCNT(j)  (256  + 64 * (j))
#define XB_XSUB(j)  (1280 + 64 * (j))
#define XB_XGEN(j)  (2304 + 64 * (j))
#define XB_TOP      3328
#define XB_TOPGEN   3392
#define XCD_BAR_WORDS 3456
#define XB_SPIN_CAP (1u << 18)

__device__ __forceinline__ unsigned xb_ld(unsigned* p)              { return __hip_atomic_load(p, __ATOMIC_RELAXED, __HIP_MEMORY_SCOPE_AGENT); }
__device__ __forceinline__ unsigned xb_add(unsigned* p, unsigned v) { return __hip_atomic_fetch_add(p, v, __ATOMIC_RELAXED, __HIP_MEMORY_SCOPE_AGENT); }
__device__ __forceinline__ unsigned xb_xcc_id() { return (unsigned)__builtin_amdgcn_s_getreg((3 << 11) | 20) & 0xFu; }
#define XB_SPIN(cond, bar) do { unsigned _sp = 0; while (cond) { __builtin_amdgcn_s_sleep(1); \
    if ((++_sp & 255u) == 0u) { if (xb_ld(&(bar)[XB_TMO])) break; if (_sp > XB_SPIN_CAP) { atomicAdd(&(bar)[XB_TMO], 1u); break; } } } } while (0)

struct XcdBarrier {
    unsigned* bar; unsigned x;
    volatile LAS unsigned* st;
};

__device__ __forceinline__ XcdBarrier xcd_barrier_post(unsigned* bar, volatile LAS unsigned* st) {
    XcdBarrier b; b.bar = bar; b.x = xb_xcc_id(); b.st = st;
    if (threadIdx.x == 0) (void)xb_add(&bar[XB_XCNT(b.x)], 1u);
    return b;
}
__device__ __forceinline__ void xcd_barrier_complete(unsigned* bar, unsigned x, unsigned& nloc, unsigned& nx) {
    const unsigned G = gridDim.x * gridDim.y * gridDim.z;
    unsigned sum, cnt, mine, sp = 0u;
    for (;;) {
        sum = 0u; cnt = 0u; mine = 0u;
#pragma unroll
        for (unsigned j = 0; j < 16; ++j) { const unsigned c = xb_ld(&bar[XB_XCNT(j)]); sum += c; cnt += (c > 0u) ? 1u : 0u; mine = (j == x) ? c : mine; }
        if (sum == G) break;
        __builtin_amdgcn_s_sleep(1);
        if ((++sp & 255u) == 0u) { if (xb_ld(&bar[XB_TMO])) break; if (sp > XB_SPIN_CAP) { atomicAdd(&bar[XB_TMO], 1u); break; } }
    }
    nloc = mine > 0u ? mine : 1u; nx = cnt > 0u ? cnt : 1u;
}

__device__ __forceinline__ void xcd_barrier(const XcdBarrier& b) {
    asm volatile("s_waitcnt vmcnt(0)" ::: "memory");
    __syncthreads();
    if (threadIdx.x == 0) {
        unsigned* bar = b.bar;
        __builtin_amdgcn_s_waitcnt(0);
        unsigned nloc = b.st[0], nx = b.st[1];
        if (nloc == 0u) { xcd_barrier_complete(bar, b.x, nloc, nx); b.st[0] = nloc; b.st[1] = nx; }
        const unsigned old = xb_add(&bar[XB_XSUB(b.x)], 1u);
        const unsigned gen = old / nloc;
        if (old + 1u == (gen + 1u) * nloc) {
            __builtin_amdgcn_fence(__ATOMIC_RELEASE, "agent");
            asm volatile("s_waitcnt vmcnt(0)" ::: "memory");
            const unsigned og = xb_add(&bar[XB_TOP], 1u);
            const unsigned tg = og / nx;
            if (og + 1u == (tg + 1u) * nx) xb_add(&bar[XB_TOPGEN], 1u);
            else XB_SPIN(xb_ld(&bar[XB_TOPGEN]) == tg, bar);
            __builtin_amdgcn_fence(__ATOMIC_ACQUIRE, "agent");
            xb_add(&bar[XB_XGEN(b.x)], 1u);
            asm volatile("s_waitcnt vmcnt(0)" ::: "memory");
        } else {
            XB_SPIN(xb_ld(&bar[XB_XGEN(b.x)]) == gen, bar);
            __builtin_amdgcn_fence(__ATOMIC_ACQUIRE, "agent");
            asm volatile("s_waitcnt vmcnt(0)" ::: "memory");
        }
    }
    __syncthreads();
}

constexpr size_t MiB = 1u << 20;
constexpr size_t WS_CTL = 0, CTL_ZERO_BYTES = 1 * MiB;
constexpr size_t WS_WIN = 2 * MiB, WS_WOUT = 26 * MiB, WS_WUP = 34 * MiB, WS_WDOWN = 66 * MiB, WS_WPLE = 98 * MiB, WS_WGATE = 100 * MiB;
constexpr size_t WS_XN = 108 * MiB;
constexpr size_t WS_PROJ = 140 * MiB;
constexpr size_t WS_XA = 232 * MiB;
constexpr size_t WS_MIX = 256 * MiB;
constexpr size_t WS_H1 = 288 * MiB;
constexpr size_t WS_HB = 352 * MiB;
constexpr size_t WS_STATES = 480 * MiB;
constexpr size_t WS_SIN = 512 * MiB;
constexpr size_t WS_E0 = 528 * MiB;
constexpr size_t WS_PB = 592 * MiB;
constexpr size_t WS_DT = 596 * MiB;
constexpr size_t WS_DTV = 597 * MiB;
constexpr size_t WS_ACS = 598 * MiB;
constexpr size_t WS_SMP = 600 * MiB;
constexpr size_t WS_PART = 604 * MiB;
constexpr size_t WS_END = 624 * MiB;
constexpr size_t SM_PROJ = 0;
constexpr size_t SM_MIX = 256 * 1024;
constexpr size_t SM_H1 = 320 * 1024;
constexpr size_t SM_HID = 384 * 1024;
constexpr size_t SM_H2 = 512 * 1024;
constexpr size_t SM_E0 = 576 * 1024;
constexpr size_t SM_GATE = 640 * 1024;
constexpr int SPROJ_LD = 5664;
constexpr int CW_TMO = 0, CW_CODE = 1, CW_BAR = 4096;
constexpr int CW_SS1 = 16384, CW_SSE = 16384 + 8192, CW_SS3 = 16384 + 16384;
constexpr size_t O_YP = 0, O_YS = 16777216, O_KP = 16793600, O_VP = 25182208, O_SP = 33570816, O_CP = 33832960, O_KS = 33842176, O_VS = 33850368, O_SS = 33858560, O_CS = 34907136, O_END = 34944000;
constexpr int LDS_BYTES = 147456, MISC_OFF = LDS_BYTES - 256;
constexpr int NWAVES = 8, NTHREADS = 512;

struct Args {
    const float* in[30];
    float* out; unsigned char* ws;
    int ph_lo, ph_hi;
};
enum { I_XP = 0, I_XS, I_PP, I_PS, I_CK, I_CV, I_PT, I_SSM, I_SCONV, I_GMIX, I_WIN, I_LQ1, I_LK1, I_LQ2, I_LK2, I_WSUB, I_CONVW, I_CONVB, I_DTB, I_ALOG, I_DSKIP, I_WSSMN, I_WOUT, I_GFFN, I_WUP, I_WDOWN, I_WPLE, I_WPLEN, I_WGATE, I_GFIN };

__device__ __forceinline__ float wave_sum(float v) {
#pragma unroll
    for (int o = 1; o < 64; o <<= 1) v += __shfl_xor(v, o);
    return v;
}
typedef float f32x2_t __attribute__((ext_vector_type(2))); typedef __bf16 bf16x2_t __attribute__((ext_vector_type(2)));
__device__ __forceinline__ unsigned cvtpk_s(float lo, float hi) { f32x2_t v = {lo, hi}; bf16x2_t b = __builtin_convertvector(v, bf16x2_t); return __builtin_bit_cast(unsigned, b); }
__device__ __forceinline__ unsigned pk2f(float lo, float hi) { return cvtpk_s(lo, hi); }
typedef short v4i16_t __attribute__((ext_vector_type(4)));
__device__ __forceinline__ float bf2f(unsigned short h) { return __uint_as_float((unsigned)h << 16); }
__device__ __forceinline__ float bflo(unsigned w) { return __uint_as_float(w << 16); }
__device__ __forceinline__ float bfhi(unsigned w) { return __uint_as_float(w & 0xffff0000u); }

__device__ __forceinline__ void p0_transpose_item(const float* W, int K, int N, int nblk, bf16* WT, LAS float* scr, int item, int lane) {
    const int kb = item / nblk, nb = item % nblk, k0 = 64 * kb, n0 = 32 * nb;
    const bool ok = (n0 + (lane & 31)) < N;
#pragma unroll 8
    for (int i = 0; i < 32; ++i) { const int kk = 2 * i + (lane >> 5); scr[kk * 33 + (lane & 31)] = ok ? W[(size_t)(k0 + kk) * N + n0 + (lane & 31)] : 0.f; }
    LDS_WAIT(); asm volatile("" ::: "memory");
    const int c = lane & 7;
#pragma unroll
    for (int j = 0; j < 4; ++j) { const int n = (lane >> 3) + 8 * j; const LAS float* s = scr + (8 * c) * 33 + n;
        v4u o; o.x = pk2f(s[0 * 33], s[1 * 33]); o.y = pk2f(s[2 * 33], s[3 * 33]); o.z = pk2f(s[4 * 33], s[5 * 33]); o.w = pk2f(s[6 * 33], s[7 * 33]);
        *(GAS v4u*)(WT + (size_t)(n0 + n) * K + k0 + 8 * c) = o; }
    LDS_WAIT(); asm volatile("" ::: "memory");
}
__device__ __forceinline__ void rms_row_to_bf16(const float* xrow, const float* g, bf16* orow, int lane) {
    const GAS f32x4* xr = (const GAS f32x4*)xrow + lane; const GAS f32x4* gr = (const GAS f32x4*)g + lane;
    f32x4 v[8]; float s = 0.f;
#pragma unroll
    for (int j = 0; j < 8; ++j) { v[j] = xr[64 * j]; s += (v[j].x * v[j].x + v[j].y * v[j].y) + (v[j].z * v[j].z + v[j].w * v[j].w); }
    const float rstd = rsqrtf(wave_sum(s) * (1.f / DMODEL) + NORM_EPS);
    GAS unsigned long long* o8 = (GAS unsigned long long*)orow + lane;
#pragma unroll
    for (int j = 0; j < 8; ++j) { const f32x4 gv = gr[64 * j]; o8[64 * j] = (unsigned long long)pk2f(v[j].x * rstd * gv.x, v[j].y * rstd * gv.y) | ((unsigned long long)pk2f(v[j].z * rstd * gv.z, v[j].w * rstd * gv.w) << 32); }
}
__device__ __forceinline__ void phase0_prologue(const Args& a, LAS unsigned char* lds, int tid, int lane, int wave, int vcu, int G) {
    LAS float* scr = (LAS float*)(lds + wave * 16384);
    const int gw = vcu * NWAVES + wave, NGW = G * NWAVES;
    unsigned char* ws = a.ws;
    constexpr int NB_IN = (NPROJ + 31) / 32;
    constexpr int I_IN = (DMODEL / 64) * NB_IN, I_OUT = (DMODEL / 64) * (DMODEL / 32), I_UP = (DMODEL / 64) * (DFF / 32), I_DN = (DFF / 64) * (DMODEL / 32), I_PL = (PLE / 64) * (DMODEL / 32), I_GT = I_OUT;
    constexpr int NITEMS = I_IN + I_OUT + I_UP + I_DN + I_PL + I_GT;
    for (int it = gw; it < NITEMS; it += NGW) {
        int r = it;
        if (r < I_IN) { p0_transpose_item(a.in[I_WIN], DMODEL, NPROJ, NB_IN, (bf16*)(ws + WS_WIN), scr, r, lane); continue; } r -= I_IN;
        if (r < I_OUT) { p0_transpose_item(a.in[I_WOUT], DMODEL, DMODEL, DMODEL / 32, (bf16*)(ws + WS_WOUT), scr, r, lane); continue; } r -= I_OUT;
        if (r < I_UP) { p0_transpose_item(a.in[I_WUP], DMODEL, DFF, DFF / 32, (bf16*)(ws + WS_WUP), scr, r, lane); continue; } r -= I_UP;
        if (r < I_DN) { p0_transpose_item(a.in[I_WDOWN], DFF, DMODEL, DMODEL / 32, (bf16*)(ws + WS_WDOWN), scr, r, lane); continue; } r -= I_DN;
        if (r < I_PL) { p0_transpose_item(a.in[I_WPLE], PLE, DMODEL, DMODEL / 32, (bf16*)(ws + WS_WPLE), scr, r, lane); continue; } r -= I_PL;
        p0_transpose_item(a.in[I_WGATE], DMODEL, DMODEL, DMODEL / 32, (bf16*)(ws + WS_WGATE), scr, r, lane);
    }
    for (int m = gw; m < MROWS; m += NGW) rms_row_to_bf16(a.in[I_XP] + (size_t)m * DMODEL, a.in[I_GMIX], (bf16*)(ws + WS_XN) + (size_t)m * DMODEL, lane);
    { const int gt = vcu * NTHREADS + tid, NGT = G * NTHREADS; const GAS f32x4* src = (const GAS f32x4*)a.in[I_PP]; GAS v4u* dst = (GAS v4u*)(ws + WS_PB);
      for (int i = gt; i < MROWS * PLE / 8; i += NGT) { const f32x4 p0 = src[2 * i], p1 = src[2 * i + 1]; v4u o; o.x = pk2f(p0.x, p0.y); o.y = pk2f(p0.z, p0.w); o.z = pk2f(p1.x, p1.y); o.w = pk2f(p1.z, p1.w); dst[i] = o; } }
}

template <int K> constexpr int sk_pitch() { return 2 * K + 64; }
template <int K> constexpr int sk_red_off() { return 8 * sk_pitch<K>(); }
template <int K, class Op>
__device__ __forceinline__ void skinny_gemm(LAS unsigned char* lds, const bf16* Bt, int ngroups, int first, int stride, int tid, int lane, int wave, const Op& op) {
    constexpr int KS = K / 8, PITCH = sk_pitch<K>();
    LAS float* red = (LAS float*)(lds + sk_red_off<K>());
    const int quad = lane >> 4, c16 = lane & 15;
    for (int cg = first; cg < ngroups; cg += stride) {
        pg8::f32x4 acc = {0.f, 0.f, 0.f, 0.f};
        const bf16* bp = Bt + (size_t)(cg * 16 + c16) * K + wave * KS + 8 * quad;
        const LAS unsigned char* ap = lds + (c16 & 7) * PITCH + (wave * KS + 8 * quad) * 2;
#pragma unroll 8
        for (int k = 0; k < KS; k += 32) {
            const bf16x8 b = *(const GAS bf16x8*)(bp + k);
            bf16x8 av = *(const LAS bf16x8*)(ap + 2 * k);
            if (c16 >= 8) av = (bf16x8){0, 0, 0, 0, 0, 0, 0, 0};
            acc = __builtin_amdgcn_mfma_f32_16x16x32_bf16(av, b, acc, 0, 0, 0);
        }
        if (quad < 2) {
#pragma unroll
            for (int j = 0; j < 4; ++j) red[(wave * 8 + 4 * quad + j) * 16 + c16] = acc[j];
        }
        __syncthreads();
        if (tid < 128) { const int r = tid >> 4, c = tid & 15; float s = 0.f;
#pragma unroll
            for (int w = 0; w < 8; ++w) s += red[(w * 8 + r) * 16 + c];
            op(r, cg * 16 + c, s); }
        __syncthreads();
    }
}
template <int K> __device__ __forceinline__ void sk_fill_rms(LAS unsigned char* lds, const float* src  , const float* g, int lane, int wave) {
    static_assert(K == 2048, "rms rows are d_model wide");
    const GAS f32x4* xr = (const GAS f32x4*)(src + (size_t)wave * K) + lane; const GAS f32x4* gr = (const GAS f32x4*)g + lane;
    f32x4 v[8]; float s = 0.f;
#pragma unroll
    for (int j = 0; j < 8; ++j) { v[j] = xr[64 * j]; s += (v[j].x * v[j].x + v[j].y * v[j].y) + (v[j].z * v[j].z + v[j].w * v[j].w); }
    const float rstd = rsqrtf(wave_sum(s) * (1.f / K) + NORM_EPS);
    LAS unsigned long long* o8 = (LAS unsigned long long*)(lds + wave * sk_pitch<K>()) + lane;
#pragma unroll
    for (int j = 0; j < 8; ++j) { const f32x4 gv = gr[64 * j]; o8[64 * j] = (unsigned long long)pk2f(v[j].x * rstd * gv.x, v[j].y * rstd * gv.y) | ((unsigned long long)pk2f(v[j].z * rstd * gv.z, v[j].w * rstd * gv.w) << 32); }
}
template <int K> __device__ __forceinline__ void sk_fill_f32(LAS unsigned char* lds, const float* src  , int tid) {
    for (int i = tid; i < 8 * K / 4; i += NTHREADS) { const int r = i / (K / 4), c4 = i % (K / 4); const f32x4 v = ((const GAS f32x4*)src)[i];
        *(LAS unsigned long long*)(lds + r * sk_pitch<K>() + c4 * 8) = (unsigned long long)pk2f(v.x, v.y) | ((unsigned long long)pk2f(v.z, v.w) << 32); }
}
template <int K> __device__ __forceinline__ void sk_fill_bf16(LAS unsigned char* lds, const bf16* src  , int tid) {
    for (int i = tid; i < 8 * K / 8; i += NTHREADS) { const int r = i / (K / 8), c8 = i % (K / 8); *(LAS v4u*)(lds + r * sk_pitch<K>() + c8 * 16) = ((const GAS v4u*)src)[i]; }
}

constexpr size_t SM_Y = 704 * 1024;
__device__ __forceinline__ float silu_f(float v) { return v / (1.f + __expf(-v)); }
__device__ __forceinline__ float softplus_f(float x) { return x > 20.f ? x : log1pf(expf(x)); }
__device__ __forceinline__ float sample_conv_act(const Args& a, const float* sproj, int b, int ch) {
    const float* sc = a.in[I_SCONV] + (size_t)b * 3 * XBC + ch; const float* cw = a.in[I_CONVW] + ch;
    const float v = a.in[I_CONVB][ch] + sc[0] * cw[0] + sc[XBC] * cw[XBC] + sc[2 * XBC] * cw[2 * XBC] + sproj[b * SPROJ_LD + C_X + ch] * cw[3 * XBC];
    return silu_f(v);
}
__device__ __forceinline__ void phase2_conv(const Args& a, LAS unsigned char* lds, int tid, int lane, int wave, int bx, int G) {
    unsigned char* ws = a.ws;
    const bf16* proj = (const bf16*)(ws + WS_PROJ); bf16* xa = (bf16*)(ws + WS_XA);
    for (int u = bx; u < MROWS / 32; u += G) {
        if (tid < 384) {
            const int cgp = tid % 192, rh = tid / 192, r0 = u * 32 + rh * 16, ch0 = cgp * 8;
            float w[4][8], bias[8];
#pragma unroll
            for (int j = 0; j < 4; ++j) { const f32x4 w0 = *(const GAS f32x4*)(a.in[I_CONVW] + j * XBC + ch0), w1 = *(const GAS f32x4*)(a.in[I_CONVW] + j * XBC + ch0 + 4);
                w[j][0] = w0.x; w[j][1] = w0.y; w[j][2] = w0.z; w[j][3] = w0.w; w[j][4] = w1.x; w[j][5] = w1.y; w[j][6] = w1.z; w[j][7] = w1.w; }
            { const f32x4 b0 = *(const GAS f32x4*)(a.in[I_CONVB] + ch0), b1 = *(const GAS f32x4*)(a.in[I_CONVB] + ch0 + 4);
              bias[0] = b0.x; bias[1] = b0.y; bias[2] = b0.z; bias[3] = b0.w; bias[4] = b1.x; bias[5] = b1.y; bias[6] = b1.z; bias[7] = b1.w; }
            v4u raw[19];
#pragma unroll
            for (int i = 0; i < 19; ++i) { const int row = r0 - 3 + i; const bool ok = (i >= 3) || ((r0 & (SEQ - 1)) != 0);
                raw[i] = ok ? *(const GAS v4u*)(proj + (size_t)row * NPAD + C_X + ch0) : (v4u){0u, 0u, 0u, 0u}; }
            float x0[8], x1[8], x2[8];
#define CV8(dst, r) do { dst[0] = bflo(r.x); dst[1] = bfhi(r.x); dst[2] = bflo(r.y); dst[3] = bfhi(r.y); dst[4] = bflo(r.z); dst[5] = bfhi(r.z); dst[6] = bflo(r.w); dst[7] = bfhi(r.w); } while (0)
            CV8(x0, raw[0]); CV8(x1, raw[1]); CV8(x2, raw[2]);
#pragma unroll
            for (int i = 3; i < 19; ++i) { float x3[8], o[8]; CV8(x3, raw[i]);
#pragma unroll
                for (int e = 0; e < 8; ++e) { o[e] = silu_f(bias[e] + x0[e] * w[0][e] + x1[e] * w[1][e] + x2[e] * w[2][e] + x3[e] * w[3][e]); x0[e] = x1[e]; x1[e] = x2[e]; x2[e] = x3[e]; }
                v4u ov; ov.x = pk2f(o[0], o[1]); ov.y = pk2f(o[2], o[3]); ov.z = pk2f(o[4], o[5]); ov.w = pk2f(o[6], o[7]);
                *(GAS v4u*)(xa + (size_t)(r0 + i - 3) * XBC + ch0) = ov; }
#undef CV8
        }
    }
    for (int u = bx; u < MROWS / 128; u += G) {
        LAS float* tot = (LAS float*)lds;
        float da[16];
        const int r = tid - 384, row = u * 128 + r;
        if (tid >= 384) {
            const float* dtr = (const float*)(ws + WS_DT) + (size_t)row * 16; float* dtv = (float*)(ws + WS_DTV) + (size_t)row * 16;
#pragma unroll
            for (int h = 0; h < 16; ++h) { const float d = softplus_f(dtr[h] + a.in[I_DTB][h]); dtv[h] = d; da[h] = -d * expf(a.in[I_ALOG][h]); }
#pragma unroll
            for (int h = 0; h < 16; ++h) {
#pragma unroll
                for (int o = 1; o < 64; o <<= 1) { const float t = __shfl_up(da[h], o); if (lane >= o) da[h] += t; } }
            if (wave == 6 && lane == 63) {
#pragma unroll
                for (int h = 0; h < 16; ++h) tot[h] = da[h]; }
        }
        __syncthreads();
        if (tid >= 384) { float* acs = (float*)(ws + WS_ACS) + (size_t)row * 16;
#pragma unroll
            for (int h = 0; h < 16; ++h) acs[h] = da[h] + (wave == 7 ? tot[h] : 0.f); }
        __syncthreads();
    }
    {
        const float* sproj = (const float*)(ws + WS_SMP + SM_PROJ); float* ysm = (float*)(ws + WS_SMP + SM_Y);
        const int gw = bx * NWAVES + wave, NGW = G * NWAVES;
        for (int rr = gw; rr < DB * 16 * 64; rr += NGW) {
            const int b = rr >> 10, h = (rr >> 6) & 15, p = rr & 63, g = h >> 3;
            const float dtv = softplus_f(sproj[b * SPROJ_LD + C_DT + h] + a.in[I_DTB][h]);
            const float dA = expf(-dtv * expf(a.in[I_ALOG][h]));
            const float xd = sample_conv_act(a, sproj, b, h * 64 + p) * dtv;
            const int n0 = 2 * lane;
            const float B0 = sample_conv_act(a, sproj, b, 1024 + g * 128 + n0), B1 = sample_conv_act(a, sproj, b, 1024 + g * 128 + n0 + 1);
            const float C0 = sample_conv_act(a, sproj, b, 1280 + g * 128 + n0), C1 = sample_conv_act(a, sproj, b, 1280 + g * 128 + n0 + 1);
            const size_t so = (size_t)rr * 128 + n0;
            const float s0 = a.in[I_SSM][so] * dA + xd * B0, s1 = a.in[I_SSM][so + 1] * dA + xd * B1;
            a.out[O_SS + so] = s0; a.out[O_SS + so + 1] = s1;
            const float y = wave_sum(s0 * C0 + s1 * C1);
            if (lane == 0) ysm[b * 1024 + h * 64 + p] = y;
        }
        const int gt = bx * NTHREADS + tid, NGT = G * NTHREADS;
        for (int i = gt; i < DB * 3 * XBC; i += NGT) { const int b = i / (3 * XBC), j = (i / XBC) % 3, ch = i % XBC;
            a.out[O_CS + i] = (j < 2) ? a.in[I_SCONV][(size_t)b * 3 * XBC + (j + 1) * XBC + ch] : sproj[b * SPROJ_LD + C_X + ch]; }
    }
}

typedef float f32x16 __attribute__((ext_vector_type(16)));
#define MFMA32(a, b, c) __builtin_amdgcn_mfma_f32_32x32x16_bf16((a), (b), (c), 0, 0, 0)
constexpr int AT_KPITCH = 1040, AT_KMAP = 8 * AT_KPITCH, AT_VD0 = 4160, AT_V = 2 * AT_KMAP, AT_STAGE = AT_V + 4 * AT_VD0;
constexpr int AT_WSF = 2 * AT_STAGE;
__device__ __forceinline__ int crow16(int i, int hi) { return (i & 3) + 8 * (i >> 2) + 4 * hi; }
__device__ __forceinline__ float diff_lambda(const Args& a, int lane) {
    const float s1 = wave_sum(a.in[I_LQ1][lane] * a.in[I_LK1][lane]), s2 = wave_sum(a.in[I_LQ2][lane] * a.in[I_LK2][lane]);
    return expf(s1) - expf(s2) + LAM_INIT;
}
__device__ __forceinline__ void attn_unit(const Args& a, LAS unsigned char* lds, int b, int h, int qb, float lam, int tid, int lane, int wave) {
    unsigned char* ws = a.ws; const bf16* proj = (const bf16*)(ws + WS_PROJ);
    const int c = wave >> 2, wq = wave & 3, r32 = lane & 31, hi = lane >> 5;
    const int q0 = qb * 128, qw0 = q0 + 32 * wq; const size_t rowb = (size_t)b * SEQ;
    const float sl2 = exp2f(-(float)(h + 1)) * LOG2E;
    bf16x8 qr[4];
    { const bf16* qp = proj + (rowb + qw0 + r32) * NPAD + C_Q + h * 128 + c * 64 + hi * 8;
#pragma unroll
      for (int d0 = 0; d0 < 4; ++d0) qr[d0] = *(const GAS bf16x8*)(qp + d0 * 16); }
    const bf16* kg = proj + rowb * NPAD + C_K + h * 128; const bf16* vg = proj + rowb * NPAD + C_V + h * 128;
    int koff[2], voff[2]; unsigned goff[2];
#pragma unroll
    for (int k = 0; k < 2; ++k) { const int i = tid + NTHREADS * k, key = i >> 4, ch = i & 15;
        goff[k] = (unsigned)(key * NPAD + ch * 8) * 2u;
        koff[k] = (ch >> 3) * AT_KMAP + (ch & 7) * AT_KPITCH + key * 16;
        voff[k] = AT_V + (ch >> 2) * AT_VD0 + (key >> 4) * 1024 + (key & 15) * 64 + (ch & 3) * 16; }
    const int nT = 2 * qb + 2;
    v4u kreg[2], vreg[2];
#define AT_LOAD(t) do { const unsigned char* kt = (const unsigned char*)(kg + (size_t)(t) * 64 * NPAD); const unsigned char* vt = (const unsigned char*)(vg + (size_t)(t) * 64 * NPAD); _Pragma("unroll") for (int k = 0; k < 2; ++k) { kreg[k] = *(const GAS v4u*)(kt + goff[k]); vreg[k] = *(const GAS v4u*)(vt + goff[k]); } } while (0)
#define AT_STORE(st) do { _Pragma("unroll") for (int k = 0; k < 2; ++k) { *(LAS v4u*)(lds + (st) * AT_STAGE + koff[k]) = kreg[k]; *(LAS v4u*)(lds + (st) * AT_STAGE + voff[k]) = vreg[k]; } } while (0)
    AT_LOAD(nT - 1); AT_STORE(0);
    __syncthreads();
    f32x16 o[4];
#pragma unroll
    for (int d = 0; d < 4; ++d)
#pragma unroll
        for (int i = 0; i < 16; ++i) o[d][i] = 0.f;
    float m = -INFINITY, lsum = 0.f;
    LAS float* wsf = (LAS float*)(lds + AT_WSF) + wave * 64;
    const int vtr = ((lane >> 4) & 1) * 32 + (lane & 3) * 8 + (4 * hi + ((lane & 15) >> 2)) * 64;
    for (int it = 0; it < nT; ++it) {
        const int t = nT - 1 - it, st = it & 1, k0 = 64 * t;
        if (it + 1 < nT) AT_LOAD(t - 1);
        if (k0 <= qw0 + 31) {
            const LAS unsigned char* Kc = lds + st * AT_STAGE + c * AT_KMAP + hi * AT_KPITCH + r32 * 16;
            f32x16 p0, p1;
#pragma unroll
            for (int i = 0; i < 16; ++i) { p0[i] = 0.f; p1[i] = 0.f; }
#pragma unroll
            for (int d0 = 0; d0 < 4; ++d0) {
                const bf16x8 a0 = *(const LAS bf16x8*)(Kc + d0 * 2 * AT_KPITCH), a1 = *(const LAS bf16x8*)(Kc + d0 * 2 * AT_KPITCH + 512);
                p0 = MFMA32(a0, qr[d0], p0); p1 = MFMA32(a1, qr[d0], p1); }
            const int dq = k0 + 4 * hi - (qw0 + r32);
            const float fb = sl2 * (float)dq;
#pragma unroll
            for (int i = 0; i < 16; ++i) { const int kk = (i & 3) + 8 * (i >> 2); p0[i] += fb + sl2 * (float)kk; p1[i] += fb + sl2 * (float)(kk + 32); }
            if (k0 + 63 > qw0) {
#pragma unroll
                for (int i = 0; i < 16; ++i) { const int kk = (i & 3) + 8 * (i >> 2); if (dq + kk > 0) p0[i] = -INFINITY; if (dq + kk + 32 > 0) p1[i] = -INFINITY; }
            }
            float mx = fmaxf(p0[0], p1[0]);
#pragma unroll
            for (int i = 1; i < 16; ++i) mx = fmaxf(mx, fmaxf(p0[i], p1[i]));
            mx = fmaxf(mx, __shfl_xor(mx, 32));
            const float mn = fmaxf(m, mx), alpha = __builtin_amdgcn_exp2f(m - mn); m = mn;
            float rs = 0.f;
#pragma unroll
            for (int i = 0; i < 16; ++i) { p0[i] = __builtin_amdgcn_exp2f(p0[i] - mn); p1[i] = __builtin_amdgcn_exp2f(p1[i] - mn); rs += p0[i] + p1[i]; }
            lsum = lsum * alpha + rs;
            if (__any(alpha != 1.f)) {
                if (hi == 0) wsf[r32] = alpha;
                asm volatile("s_waitcnt lgkmcnt(0)" ::: "memory");
#pragma unroll
                for (int g4 = 0; g4 < 4; ++g4) { const f32x4 al = *(const LAS f32x4*)(wsf + 8 * g4 + 4 * hi);
#pragma unroll
                    for (int d = 0; d < 4; ++d) { o[d][4 * g4 + 0] *= al.x; o[d][4 * g4 + 1] *= al.y; o[d][4 * g4 + 2] *= al.z; o[d][4 * g4 + 3] *= al.w; } }
            }
            bf16x8 pa[4];
            { v4u w;
              w.x = cvtpk_s(p0[0], p0[1]); w.y = cvtpk_s(p0[2], p0[3]); w.z = cvtpk_s(p0[4], p0[5]); w.w = cvtpk_s(p0[6], p0[7]); pa[0] = __builtin_bit_cast(bf16x8, w);
              w.x = cvtpk_s(p0[8], p0[9]); w.y = cvtpk_s(p0[10], p0[11]); w.z = cvtpk_s(p0[12], p0[13]); w.w = cvtpk_s(p0[14], p0[15]); pa[1] = __builtin_bit_cast(bf16x8, w);
              w.x = cvtpk_s(p1[0], p1[1]); w.y = cvtpk_s(p1[2], p1[3]); w.z = cvtpk_s(p1[4], p1[5]); w.w = cvtpk_s(p1[6], p1[7]); pa[2] = __builtin_bit_cast(bf16x8, w);
              w.x = cvtpk_s(p1[8], p1[9]); w.y = cvtpk_s(p1[10], p1[11]); w.z = cvtpk_s(p1[12], p1[13]); w.w = cvtpk_s(p1[14], p1[15]); pa[3] = __builtin_bit_cast(bf16x8, w); }
            const LAS unsigned char* Vb = lds + st * AT_STAGE + AT_V + vtr;
#pragma unroll
            for (int d = 0; d < 4; ++d)
#pragma unroll
                for (int ks = 0; ks < 4; ++ks) {
                    const v4i16_t lo = __builtin_amdgcn_ds_read_tr16_b64_v4i16((LAS v4i16_t*)(Vb + d * AT_VD0 + ks * 1024));
                    const v4i16_t hv = __builtin_amdgcn_ds_read_tr16_b64_v4i16((LAS v4i16_t*)(Vb + d * AT_VD0 + ks * 1024 + 512));
                    const bf16x8 vb = (bf16x8){lo[0], lo[1], lo[2], lo[3], hv[0], hv[1], hv[2], hv[3]};
                    o[d] = MFMA32(pa[ks], vb, o[d]); }
        }
        if (it + 1 < nT) AT_STORE(st ^ 1);
        __syncthreads();
    }
#undef AT_LOAD
#undef AT_STORE
    const float ltot = lsum + __shfl_xor(lsum, 32);
    const float fac = (c == 0 ? 1.f : -lam) / ltot;
    if (hi == 0) wsf[r32] = fac;
    asm volatile("s_waitcnt lgkmcnt(0)" ::: "memory");
#pragma unroll
    for (int g4 = 0; g4 < 4; ++g4) { const f32x4 al = *(const LAS f32x4*)(wsf + 8 * g4 + 4 * hi);
#pragma unroll
        for (int d = 0; d < 4; ++d) { o[d][4 * g4 + 0] *= al.x; o[d][4 * g4 + 1] *= al.y; o[d][4 * g4 + 2] *= al.z; o[d][4 * g4 + 3] *= al.w; } }
    LAS float* xb = (LAS float*)lds + wq * 4096;
    LAS float* xbl = xb + (4 * hi) * 128 + r32;
    if (c == 1) {
#pragma unroll
        for (int d = 0; d < 4; ++d)
#pragma unroll
            for (int i = 0; i < 16; ++i) xbl[((i & 3) + 8 * (i >> 2)) * 128 + 32 * d] = o[d][i];
    }
    __syncthreads();
    if (c == 0) {
        float ssq[16];
#pragma unroll
        for (int i = 0; i < 16; ++i) { ssq[i] = 0.f;
#pragma unroll
            for (int d = 0; d < 4; ++d) { o[d][i] += xbl[((i & 3) + 8 * (i >> 2)) * 128 + 32 * d]; ssq[i] += o[d][i] * o[d][i]; } }
#pragma unroll
        for (int i = 0; i < 16; ++i) {
#pragma unroll
            for (int x = 1; x < 32; x <<= 1) ssq[i] += __shfl_xor(ssq[i], x);
            ssq[i] = rsqrtf(ssq[i] * (1.f / 128.f) + SUBLN_EPS) * (1.f - LAM_INIT); }
        LAS unsigned short* ob = (LAS unsigned short*)xb;
        LAS unsigned short* obl = ob + (4 * hi) * 128 + r32;
#pragma unroll
        for (int d = 0; d < 4; ++d) { const float wsub = a.in[I_WSUB][32 * d + r32];
#pragma unroll
            for (int i = 0; i < 16; ++i) obl[((i & 3) + 8 * (i >> 2)) * 128 + 32 * d] = (unsigned short)(cvtpk_s(o[d][i] * ssq[i] * wsub, 0.f) & 0xffffu); }
        asm volatile("s_waitcnt lgkmcnt(0)" ::: "memory");
        bf16* mix = (bf16*)(ws + WS_MIX);
#pragma unroll
        for (int k = 0; k < 8; ++k) { const int i = lane + 64 * k, row = i >> 4, ch = i & 15;
            *(GAS v4u*)(mix + (rowb + qw0 + row) * DMODEL + h * 128 + ch * 8) = *(const LAS v4u*)((const LAS unsigned char*)ob + row * 256 + ch * 16); }
    }
    __syncthreads();
}

constexpr int TP = 272, TILE_BYTES = 128 * TP;
__device__ __forceinline__ unsigned row_lane_off(unsigned lane) { return (lane & 15) * TP + (lane >> 4) * 16; }
__device__ __forceinline__ unsigned tr_lane_off(unsigned lane) { return (8 * (lane >> 4) + ((lane & 15) >> 2)) * TP + (lane & 3) * 8; }
__device__ __forceinline__ bf16x8 lds_row_frag(const LAS unsigned char* tl  , int rb, int s) { return *(const LAS bf16x8*)(tl + rb * 16 * TP + s * 64); }
__device__ __forceinline__ bf16x8 lds_tr_frag(const LAS unsigned char* tl  , int c, int ks) {
    const v4i16_t lo = __builtin_amdgcn_ds_read_tr16_b64_v4i16((LAS v4i16_t*)(tl + (32 * ks) * TP + c * 32));
    const v4i16_t hi = __builtin_amdgcn_ds_read_tr16_b64_v4i16((LAS v4i16_t*)(tl + (32 * ks + 4) * TP + c * 32));
    return (bf16x8){lo[0], lo[1], lo[2], lo[3], hi[0], hi[1], hi[2], hi[3]};
}
#define MFMA16(a, b, c) __builtin_amdgcn_mfma_f32_16x16x32_bf16((a), (b), (c), 0, 0, 0)

__device__ __forceinline__ void stage_tile_plain(LAS unsigned char* tile, const bf16* src, int ld, int tid) {
#pragma unroll
    for (int k = 0; k < 4; ++k) { const int r = (tid >> 4) + 32 * k, ch = tid & 15; *(LAS v4u*)(tile + (tid >> 4) * TP + ch * 16 + k * 32 * TP) = *(const GAS v4u*)(src + (size_t)r * ld + ch * 8); }
}
__device__ __forceinline__ v4u scale8(v4u r, float w) {
    v4u o; o.x = pk2f(bflo(r.x) * w, bfhi(r.x) * w); o.y = pk2f(bflo(r.y) * w, bfhi(r.y) * w); o.z = pk2f(bflo(r.z) * w, bfhi(r.z) * w); o.w = pk2f(bflo(r.w) * w, bfhi(r.w) * w); return o;
}

__device__ __forceinline__ void ssd_states_unit(const Args& a, LAS unsigned char* lds, int u, int tid, int lane, int wave) {
    unsigned char* ws = a.ws;
    const int b = u >> 7, c = (u >> 2) & 31, g = (u >> 1) & 1, half = u & 1; const int R0 = b * SEQ + c * 128;
    const bf16* xa = (const bf16*)(ws + WS_XA); const float* dtv = (const float*)(ws + WS_DTV); const float* acs = (const float*)(ws + WS_ACS);
    LAS unsigned char* Bt = lds; LAS unsigned char* Xt = lds + TILE_BYTES;
    const LAS unsigned char* Btr = Bt + tr_lane_off(lane); const LAS unsigned char* Xtr = Xt + tr_lane_off(lane);
    stage_tile_plain(Bt, xa + (size_t)R0 * XBC + 1024 + g * 128, XBC, tid);
    for (int hp = 0; hp < 2; ++hp) {
        const int h0 = g * 8 + half * 4 + hp * 2;
        { const int ch = tid & 15, h = h0 + (ch >> 3); const float alast = acs[(size_t)(R0 + 127) * 16 + h];
#pragma unroll
          for (int k = 0; k < 4; ++k) { const int s = (tid + NTHREADS * k) >> 4; const size_t ro = (size_t)(R0 + s);
              const float w = dtv[ro * 16 + h] * __expf(alast - acs[ro * 16 + h]);
              const v4u raw = *(const GAS v4u*)(xa + ro * XBC + h * 64 + (ch & 7) * 8);
              *(LAS v4u*)(Xt + (tid >> 4) * TP + ch * 16 + k * 32 * TP) = scale8(raw, w); } }
        __syncthreads();
        const int hh = wave >> 2, pblk = wave & 3;
        pg8::f32x4 acc[8];
#pragma unroll
        for (int nb = 0; nb < 8; ++nb) acc[nb] = (pg8::f32x4){0.f, 0.f, 0.f, 0.f};
#pragma unroll
        for (int ks = 0; ks < 4; ++ks) { const bf16x8 af = lds_tr_frag(Xtr + (hh * 4 + pblk) * 32, 0, ks);
#pragma unroll
            for (int nb = 0; nb < 8; ++nb) { const bf16x8 bfr = lds_tr_frag(Btr, nb, ks); acc[nb] = MFMA16(af, bfr, acc[nb]); } }
        float* st = (float*)(ws + WS_STATES) + ((size_t)((b * 32 + c) * 16 + h0 + hh)) * 8192;
#pragma unroll
        for (int nb = 0; nb < 8; ++nb)
#pragma unroll
            for (int j = 0; j < 4; ++j) st[(16 * pblk + 4 * (lane >> 4) + j) * 128 + 16 * nb + (lane & 15)] = acc[nb][j];
        __syncthreads();
    }
}

__device__ __forceinline__ void ssd_scan(const Args& a, int tid, int bx, int G) {
    unsigned char* ws = a.ws; typedef float f32x2 __attribute__((ext_vector_type(2)));
    const int NGT = G * NTHREADS;
    for (int i = bx * NTHREADS + tid; i < 2 * 16 * 64 * 64; i += NGT) {
        const int n2 = i & 63, p = (i >> 6) & 63, h = (i >> 12) & 15, b = i >> 16;
        const size_t eo = (size_t)p * 128 + 2 * n2;
        f32x2 st[32]; float dec[32];
#pragma unroll
        for (int c = 0; c < 32; ++c) { st[c] = *(const GAS f32x2*)((const float*)(ws + WS_STATES) + ((size_t)((b * 32 + c) * 16 + h)) * 8192 + eo);
            dec[c] = ((const float*)(ws + WS_ACS))[(size_t)(b * SEQ + c * 128 + 127) * 16 + h]; }
        f32x2 carry = {0.f, 0.f};
#pragma unroll
        for (int c = 0; c < 32; ++c) {
            *(GAS unsigned*)((bf16*)(ws + WS_SIN) + ((size_t)((b * 32 + c) * 16 + h)) * 8192 + eo) = pk2f(carry.x, carry.y);
            const float d = __expf(dec[c]); carry.x = carry.x * d + st[c].x; carry.y = carry.y * d + st[c].y; }
        *(GAS f32x2*)(a.out + O_SP + ((size_t)(b * 16 + h) * 64) * 128 + eo) = carry;
    }
}

__device__ __forceinline__ void ssd_out_unit(const Args& a, LAS unsigned char* lds, int u, int tid, int lane, int wave) {
    unsigned char* ws = a.ws;
    const int b = u >> 6, c = (u >> 1) & 31, g = u & 1; const int R0 = b * SEQ + c * 128;
    const bf16* xa = (const bf16*)(ws + WS_XA); const bf16* proj = (const bf16*)(ws + WS_PROJ); const float* dtv = (const float*)(ws + WS_DTV);
    bf16* mix = (bf16*)(ws + WS_MIX);
    LAS unsigned char* Ct = lds; LAS unsigned char* Bt = lds + TILE_BYTES; LAS unsigned char* Xd = lds + TILE_BYTES; LAS unsigned char* Sn = lds + 2 * TILE_BYTES;
    LAS unsigned char* Gw = lds + 3 * TILE_BYTES + wave * 16 * TP; LAS float* acsl = (LAS float*)(lds + 4 * TILE_BYTES);
    const unsigned rlo = row_lane_off(lane), tlo = tr_lane_off(lane);
    const LAS unsigned char* Cw = Ct + rlo + wave * 16 * TP; const LAS unsigned char* Br = Bt + rlo; const LAS unsigned char* Xtr = Xd + tlo; const LAS unsigned char* Snr = Sn + rlo; const LAS unsigned char* Gr = Gw + rlo;
    stage_tile_plain(Ct, xa + (size_t)R0 * XBC + 1280 + g * 128, XBC, tid);
    stage_tile_plain(Bt, xa + (size_t)R0 * XBC + 1024 + g * 128, XBC, tid);
    for (int i = tid; i < 128 * 8 / 4; i += NTHREADS) ((LAS f32x4*)acsl)[i] = *(const GAS f32x4*)((const float*)(ws + WS_ACS) + (size_t)(R0 + (i >> 1)) * 16 + g * 8 + (i & 1) * 4);
    __syncthreads();
    const int q = lane >> 4, c16 = lane & 15;
    pg8::f32x4 cb[8];
#pragma unroll
    for (int sb = 0; sb < 8; ++sb) cb[sb] = (pg8::f32x4){0.f, 0.f, 0.f, 0.f};
#pragma unroll
    for (int ks = 0; ks < 4; ++ks) { const bf16x8 af = lds_row_frag(Cw, 0, ks);
#pragma unroll
        for (int sb = 0; sb < 8; ++sb) if (sb <= wave) { const bf16x8 bfr = lds_row_frag(Br, sb, ks); cb[sb] = MFMA16(af, bfr, cb[sb]); } }
    __syncthreads();
    float ss[4] = {0.f, 0.f, 0.f, 0.f};
    const int nks = (wave >> 1) + 1;
    for (int hp = 0; hp < 4; ++hp) {
        const int h0 = g * 8 + hp * 2;
        { const int ch = tid & 15, h = h0 + (ch >> 3);
#pragma unroll
          for (int k = 0; k < 4; ++k) { const int s = (tid + NTHREADS * k) >> 4; const size_t ro = (size_t)(R0 + s);
              const v4u raw = *(const GAS v4u*)(xa + ro * XBC + h * 64 + (ch & 7) * 8);
              *(LAS v4u*)(Xd + (tid >> 4) * TP + ch * 16 + k * 32 * TP) = scale8(raw, dtv[ro * 16 + h]); }
          stage_tile_plain(Sn, (const bf16*)(ws + WS_SIN) + ((size_t)((b * 32 + c) * 16 + h0)) * 8192, 128, tid); }
        __syncthreads();
#pragma unroll
        for (int hh = 0; hh < 2; ++hh) {
            const int h = h0 + hh;
            float al[4];
#pragma unroll
            for (int j = 0; j < 4; ++j) al[j] = acsl[(16 * wave + 4 * q + j) * 8 + (h & 7)];
#pragma unroll
            for (int sb = 0; sb < 8; ++sb) if (sb < 2 * nks) { const int s = 16 * sb + c16; const float as = acsl[s * 8 + (h & 7)];
#pragma unroll
                for (int j = 0; j < 4; ++j) { const int l = 16 * wave + 4 * q + j; const float gv = (sb <= wave && s <= l) ? cb[sb][j] * __expf(al[j] - as) : 0.f;
                    *(LAS unsigned short*)(Gw + (4 * q) * TP + c16 * 2 + j * TP + sb * 32) = (unsigned short)(pk2f(gv, 0.f) & 0xffffu); } }
            asm volatile("s_waitcnt lgkmcnt(0)" ::: "memory");
            pg8::f32x4 yd[4], yo[4];
#pragma unroll
            for (int pb = 0; pb < 4; ++pb) { yd[pb] = (pg8::f32x4){0.f, 0.f, 0.f, 0.f}; yo[pb] = (pg8::f32x4){0.f, 0.f, 0.f, 0.f}; }
#pragma unroll
            for (int ks = 0; ks < 4; ++ks) if (ks < nks) { const bf16x8 af = lds_row_frag(Gr, 0, ks);
#pragma unroll
                for (int pb = 0; pb < 4; ++pb) { const bf16x8 bfr = lds_tr_frag(Xtr + hh * 128, pb, ks); yd[pb] = MFMA16(af, bfr, yd[pb]); } }
#pragma unroll
            for (int ks = 0; ks < 4; ++ks) { const bf16x8 af = lds_row_frag(Cw, 0, ks);
#pragma unroll
                for (int pb = 0; pb < 4; ++pb) { const bf16x8 bfr = lds_row_frag(Snr + hh * 64 * TP, pb, ks); yo[pb] = MFMA16(af, bfr, yo[pb]); } }
            const float dsk = a.in[I_DSKIP][h];
#pragma unroll
            for (int j = 0; j < 4; ++j) { const int l = 16 * wave + 4 * q + j; const size_t ro = (size_t)(R0 + l); const float ea = __expf(al[j]);
#pragma unroll
                for (int pb = 0; pb < 4; ++pb) { const int p = 16 * pb + c16;
                    const float xv = bf2f(xa[ro * XBC + h * 64 + p]), zv = bf2f(proj[ro * NPAD + C_Z + h * 64 + p]);
                    const float y = yd[pb][j] + ea * yo[pb][j] + dsk * xv; const float gv = y * silu_f(zv);
                    ss[j] += gv * gv; mix[ro * DMODEL + 1024 + h * 64 + p] = (bf16)(pk2f(gv, 0.f) & 0xffffu); } }
        }
        __syncthreads();
    }
#pragma unroll
    for (int j = 0; j < 4; ++j) { float s = ss[j]; s += __shfl_xor(s, 1); s += __shfl_xor(s, 2); s += __shfl_xor(s, 4); s += __shfl_xor(s, 8); ss[j] = rsqrtf(s * (1.f / 512.f) + NORM_EPS); }
    asm volatile("s_waitcnt vmcnt(0)" ::: "memory");
    for (int hl = 0; hl < 8; ++hl) { const int h = g * 8 + hl;
#pragma unroll
        for (int j = 0; j < 4; ++j) { const size_t ro = (size_t)(R0 + 16 * wave + 4 * q + j);
#pragma unroll
            for (int pb = 0; pb < 4; ++pb) { const int p = 16 * pb + c16; bf16* mp = mix + ro * DMODEL + 1024 + h * 64 + p;
                const float v = bf2f(*(volatile bf16*)mp) * ss[j] * a.in[I_WSSMN][h * 64 + p]; *mp = (bf16)(pk2f(v, 0.f) & 0xffffu); } } }
}
__device__ __forceinline__ void phase5_ssd_out(const Args& a, LAS unsigned char* lds, int tid, int lane, int wave, int bx, int G) {
    for (int u = bx; u < 128; u += G) { ssd_out_unit(a, lds, u, tid, lane, wave); __syncthreads(); }
}

constexpr size_t PART_ML = 0, PART_O = 1 * MiB;
__device__ __forceinline__ void sattn_partial_unit(const Args& a, LAS unsigned char* lds, int u, int tid, int lane, int wave) {
    unsigned char* ws = a.ws;
    const int b = u >> 7, pg = u & 127;
    const int pid = ((const int*)a.in[I_PT])[b * NPAGES + pg];
    const float* kp = a.in[I_CK] + (size_t)pid * PAGE * 1024; const float* vp = a.in[I_CV] + (size_t)pid * PAGE * 1024;
    const float* sproj = (const float*)(ws + WS_SMP + SM_PROJ);
    LAS float* S = (LAS float*)(lds);
    LAS float* red = (LAS float*)(lds + 16384);
    f32x4 qv[4];
#pragma unroll
    for (int i = 0; i < 4; ++i) { const f32x4 t = *(const GAS f32x4*)(sproj + b * SPROJ_LD + C_Q + 4 * lane + 256 * i); qv[i] = t * QSCALE; }
#pragma unroll 4
    for (int tt = 0; tt < 16; ++tt) { const int tok = wave * 16 + tt; const float* kr = kp + (size_t)tok * 1024 + 4 * lane;
        float part[4];
#pragma unroll
        for (int i = 0; i < 4; ++i) { const f32x4 kv = __builtin_nontemporal_load((const GAS f32x4*)(kr + 256 * i)); part[i] = (kv.x * qv[i].x + kv.y * qv[i].y) + (kv.z * qv[i].z + kv.w * qv[i].w); }
#pragma unroll
        for (int i = 0; i < 4; ++i) { float s = part[i]; s += __shfl_xor(s, 1); s += __shfl_xor(s, 2); s += __shfl_xor(s, 4); s += __shfl_xor(s, 8); part[i] = s; }
        if ((lane & 15) == 0) {
            const float dist = (float)(PAST - (pg * PAGE + tok));
#pragma unroll
            for (int i = 0; i < 4; ++i) { const int head = (lane >> 5) + 2 * i, mp = (lane >> 4) & 1; S[tok * 16 + head * 2 + mp] = part[i] - exp2f(-(float)(head + 1)) * LOG2E * dist; } }
    }
    __syncthreads();
    { const int hc = 2 * wave + (lane >> 5), t0 = lane & 31; float sv[4]; float mx = -INFINITY;
#pragma unroll
      for (int k = 0; k < 4; ++k) { sv[k] = S[(t0 + 32 * k) * 16 + hc]; mx = fmaxf(mx, sv[k]); }
#pragma unroll
      for (int x = 1; x < 32; x <<= 1) mx = fmaxf(mx, __shfl_xor(mx, x));
      float ls = 0.f;
#pragma unroll
      for (int k = 0; k < 4; ++k) { sv[k] = exp2f(sv[k] - mx); ls += sv[k]; S[(t0 + 32 * k) * 16 + hc] = sv[k]; }
#pragma unroll
      for (int x = 1; x < 32; x <<= 1) ls += __shfl_xor(ls, x);
      if (t0 == 0) { float* ml = (float*)(ws + WS_PART + PART_ML) + ((size_t)u * 16 + hc) * 2; ml[0] = mx; ml[1] = ls; } }
    __syncthreads();
    f32x4 acc[4][2];
#pragma unroll
    for (int i = 0; i < 4; ++i) { acc[i][0] = (f32x4){0.f, 0.f, 0.f, 0.f}; acc[i][1] = (f32x4){0.f, 0.f, 0.f, 0.f}; }
#pragma unroll 4
    for (int tt = 0; tt < 16; ++tt) { const int tok = wave * 16 + tt; const float* vr = vp + (size_t)tok * 1024 + 4 * lane;
#pragma unroll
        for (int i = 0; i < 4; ++i) { const f32x4 vv = __builtin_nontemporal_load((const GAS f32x4*)(vr + 256 * i)); const int head = (lane >> 5) + 2 * i;
            const float p0 = S[tok * 16 + head * 2], p1 = S[tok * 16 + head * 2 + 1];
            acc[i][0] += vv * p0; acc[i][1] += vv * p1; } }
#pragma unroll
    for (int i = 0; i < 4; ++i) { const int head = (lane >> 5) + 2 * i;
#pragma unroll
        for (int mp = 0; mp < 2; ++mp) *(LAS f32x4*)(red + ((wave * 16 + head * 2 + mp) * 128 + 4 * (lane & 31))) = acc[i][mp]; }
    __syncthreads();
    { float* po = (float*)(ws + WS_PART + PART_O) + (size_t)u * 2048;
      const int e = tid * 4; f32x4 s = {0.f, 0.f, 0.f, 0.f};
#pragma unroll
      for (int w = 0; w < 8; ++w) s += *(const LAS f32x4*)(red + w * 2048 + e);
      *(GAS f32x4*)(po + e) = s; }
    __syncthreads();
}
__device__ __forceinline__ void sattn_combine_wave(const Args& a, int bh, float lam, int lane) {
    unsigned char* ws = a.ws; const int b = bh >> 3, h = bh & 7;
    const float* sproj = (const float*)(ws + WS_SMP + SM_PROJ) + b * SPROJ_LD;
    const float* ml = (const float*)(ws + WS_PART + PART_ML); const float* po = (const float*)(ws + WS_PART + PART_O);
    float on[2][2];
#pragma unroll
    for (int mp = 0; mp < 2; ++mp) {
        const float snew = wave_sum(sproj[C_Q + h * 128 + mp * 64 + lane] * QSCALE * sproj[C_K + h * 128 + mp * 64 + lane]);
        const int hc = h * 2 + mp;
        const float m0 = ml[((size_t)(b * 128 + lane) * 16 + hc) * 2], m1 = ml[((size_t)(b * 128 + lane + 64) * 16 + hc) * 2];
        const float l0 = ml[((size_t)(b * 128 + lane) * 16 + hc) * 2 + 1], l1 = ml[((size_t)(b * 128 + lane + 64) * 16 + hc) * 2 + 1];
        float mg = fmaxf(fmaxf(m0, m1), snew);
#pragma unroll
        for (int x = 1; x < 64; x <<= 1) mg = fmaxf(mg, __shfl_xor(mg, x));
        const float w0 = exp2f(m0 - mg), w1 = exp2f(m1 - mg), wn = exp2f(snew - mg);
        const float L = wave_sum(l0 * w0 + l1 * w1) + wn;
        float o0 = wn * sproj[C_V + h * 128 + 2 * lane], o1 = wn * sproj[C_V + h * 128 + 2 * lane + 1];
        for (int j = 0; j < 64; ++j) { const float wa = __shfl(w0, j), wb = __shfl(w1, j);
            const f32x2_t pa = *(const GAS f32x2_t*)(po + ((size_t)(b * 128 + j) * 16 + hc) * 128 + 2 * lane), pb = *(const GAS f32x2_t*)(po + ((size_t)(b * 128 + j + 64) * 16 + hc) * 128 + 2 * lane);
            o0 += wa * pa.x + wb * pb.x; o1 += wa * pa.y + wb * pb.y; }
        on[mp][0] = o0 / L; on[mp][1] = o1 / L;
    }
    const float d0 = on[0][0] - lam * on[1][0], d1 = on[0][1] - lam * on[1][1];
    const float rn = rsqrtf(wave_sum(d0 * d0 + d1 * d1) * (1.f / 128.f) + SUBLN_EPS) * (1.f - LAM_INIT);
    unsigned* mixs = (unsigned*)((bf16*)(ws + WS_SMP + SM_MIX) + b * DMODEL + h * 128 + 2 * lane);
    *mixs = cvtpk_s(d0 * rn * a.in[I_WSUB][2 * lane], d1 * rn * a.in[I_WSUB][2 * lane + 1]);
}
__device__ __forceinline__ void sssm_out_wave(const Args& a, int bg, int lane) {
    unsigned char* ws = a.ws; const int b = bg >> 1, g = bg & 1;
    const float* sproj = (const float*)(ws + WS_SMP + SM_PROJ); const float* ysm = (const float*)(ws + WS_SMP + SM_Y);
    float gv[8]; float ss = 0.f;
#pragma unroll
    for (int e = 0; e < 8; ++e) { const int ch = g * 512 + lane * 8 + e; const float xs = sample_conv_act(a, sproj, b, ch);
        const float y = ysm[b * 1024 + ch] + a.in[I_DSKIP][ch >> 6] * xs; gv[e] = y * silu_f(sproj[b * SPROJ_LD + C_Z + ch]); ss += gv[e] * gv[e]; }
    const float rn = rsqrtf(wave_sum(ss) * (1.f / 512.f) + NORM_EPS);
    v4u o; float w[8];
#pragma unroll
    for (int e = 0; e < 8; ++e) w[e] = gv[e] * rn * a.in[I_WSSMN][g * 512 + lane * 8 + e];
    o.x = cvtpk_s(w[0], w[1]); o.y = cvtpk_s(w[2], w[3]); o.z = cvtpk_s(w[4], w[5]); o.w = cvtpk_s(w[6], w[7]);
    *(GAS v4u*)((bf16*)(ws + WS_SMP + SM_MIX) + b * DMODEL + 1024 + g * 512 + lane * 8) = o;
}

__device__ __forceinline__ void phase3_attn_states(const Args& a, LAS unsigned char* lds, int tid, int lane, int wave, int bx, int G) {
    const float lam = diff_lambda(a, lane);
#ifndef P3SEL
#define P3SEL 7
#endif
    if (P3SEL & 1) for (int j = bx; j < 256; j += G) { const int bh = j >> 4, k = j & 15;
        attn_unit(a, lds, bh >> 3, bh & 7, 31 - k, lam, tid, lane, wave);
        attn_unit(a, lds, bh >> 3, bh & 7, k, lam, tid, lane, wave); }
    asm volatile("" : "+v"(tid), "+v"(lane));
    if (P3SEL & 2) for (int u = bx; u < 256; u += G) { ssd_states_unit(a, lds, u, tid, lane, wave); }
    asm volatile("" : "+v"(tid), "+v"(lane));
    if (P3SEL & 4) for (int u = bx; u < DB * NPAGES; u += G) sattn_partial_unit(a, lds, u, tid, lane, wave);
}
__device__ __forceinline__ void phase4_scan(const Args& a, LAS unsigned char* lds, int tid, int lane, int wave, int bx, int G) {
    ssd_scan(a, tid, bx, G);
    const int gw = bx * NWAVES + wave, NGW = G * NWAVES;
    const float lam = diff_lambda(a, lane);
    for (int i = gw; i < 64 + 16; i += NGW) { if (i < 64) sattn_combine_wave(a, i, lam, lane); else sssm_out_wave(a, i - 64, lane); }
}

constexpr int N_PHASES = 11;
__global__ void __launch_bounds__(NTHREADS, 2) hymba_fwd(Args args) {
    extern __shared__ __attribute__((aligned(16))) unsigned char lds_raw[];
    LAS unsigned char* lds = (LAS unsigned char*)lds_raw;
    const int tid = threadIdx.x, lane = tid & 63, wave = __builtin_amdgcn_readfirstlane(tid >> 6);
    const int G = gridDim.x; const int bx = blockIdx.x; const int vcu = (G % 8 == 0) ? (bx % 8) * (G / 8) + bx / 8 : bx;
    unsigned char* ws = args.ws; gu32* ctl = (gu32*)(ws + WS_CTL);
    volatile LAS unsigned* MISC = (volatile LAS unsigned*)(lds + MISC_OFF);
    if (tid < 16) MISC[tid] = 0u;
    __syncthreads();
#if MK_SPLIT
#define GRID_BAR() do { } while (0)
#else
    XcdBarrier bar = xcd_barrier_post((unsigned*)(ctl + CW_BAR), MISC + 8);
#define GRID_BAR() xcd_barrier(bar)
#endif
    const int lo = args.ph_lo, hi = args.ph_hi;
#ifndef PHMASK
#define PHMASK 0xffff
#endif
#define IN(k) (((PHMASK >> (k)) & 1) && lo <= (k) && (k) < hi)
#define BOTH(k) (IN(k) && IN((k) + 1))
    float* out = args.out;
    float* ss1 = (float*)(ctl + CW_SS1); float* sse = (float*)(ctl + CW_SSE); float* ss3 = (float*)(ctl + CW_SS3);
    unsigned char* smp = ws + WS_SMP;

    if (IN(0)) { phase0_prologue(args, lds, tid, lane, wave, vcu, G); if (BOTH(0)) GRID_BAR(); }

    if (IN(1)) {
        { pg8::Gemm g{(const pg8::bf16_t*)(ws + WS_XN), (const pg8::bf16_t*)(ws + WS_WIN), MROWS, NPAD, DMODEL}; pg8::StaticOrder S; S.init(MROWS, NPAD, G, bx);
          pg8::EpiProj E{(pg8::bf16_t*)(ws + WS_PROJ), out + O_KP, out + O_VP, out + O_CP, (float*)(ws + WS_DT)};
          pg8::gemm_phase<pg8::EpiProj, pg8::StaticOrder, true, true>(lds, g, S, E); }
        __syncthreads();
        { sk_fill_rms<DMODEL>(lds, args.in[I_XS], args.in[I_GMIX], lane, wave); __syncthreads();
          float* sp = (float*)(smp + SM_PROJ); float* ks = out + O_KS; float* vs = out + O_VS;
          auto op = [=](int r, int col, float v) { sp[r * SPROJ_LD + col] = v; if (col >= C_K && col < C_V) ks[r * 1024 + col - C_K] = v; else if (col >= C_V && col < C_Z) vs[r * 1024 + col - C_V] = v; };
          skinny_gemm<DMODEL>(lds, (const bf16*)(ws + WS_WIN), NPROJ / 16, bx, G, tid, lane, wave, op); }
        if (BOTH(1)) GRID_BAR();
    }
    if (IN(2)) { phase2_conv(args, lds, tid, lane, wave, bx, G); if (BOTH(2)) GRID_BAR(); }
    if (IN(3)) { phase3_attn_states(args, lds, tid, lane, wave, bx, G); if (BOTH(3)) GRID_BAR(); }
    if (IN(4)) { phase4_scan(args, lds, tid, lane, wave, bx, G); if (BOTH(4)) GRID_BAR(); }
    if (IN(5)) {
        phase5_ssd_out(args, lds, tid, lane, wave, bx, G);
        __syncthreads();
        { pg8::Gemm g{(const pg8::bf16_t*)(ws + WS_PB), (const pg8::bf16_t*)(ws + WS_WPLE), MROWS, DMODEL, PLE}; pg8::StaticOrder S; S.init(MROWS, DMODEL, G, bx);
          pg8::EpiPle E{(float*)(ws + WS_E0), sse};
          pg8::gemm_phase<pg8::EpiPle, pg8::StaticOrder, true, true>(lds, g, S, E); }
        __syncthreads();
        { sk_fill_bf16<DMODEL>(lds, (const bf16*)(smp + SM_MIX), tid); __syncthreads();
          float* h1s = (float*)(smp + SM_H1); const float* xs = args.in[I_XS];
          auto op = [=](int r, int col, float v) { h1s[r * DMODEL + col] = xs[r * DMODEL + col] + v; };
          skinny_gemm<DMODEL>(lds, (const bf16*)(ws + WS_WOUT), DMODEL / 16, bx, G, tid, lane, wave, op); }
        if (BOTH(5)) GRID_BAR();
    }
    if (IN(6)) {
        { pg8::Gemm g{(const pg8::bf16_t*)(ws + WS_MIX), (const pg8::bf16_t*)(ws + WS_WOUT), MROWS, DMODEL, DMODEL}; pg8::StaticOrder S; S.init(MROWS, DMODEL, G, bx);
          pg8::EpiOut E{args.in[I_XP], (float*)(ws + WS_H1), (pg8::bf16_t*)(ws + WS_XN), args.in[I_GFFN], ss1};
          pg8::gemm_phase<pg8::EpiOut, pg8::StaticOrder, true, true>(lds, g, S, E); }
        __syncthreads();
        { sk_fill_rms<DMODEL>(lds, (const float*)(smp + SM_H1), args.in[I_GFFN], lane, wave); __syncthreads();
          bf16* hid = (bf16*)(smp + SM_HID);
          auto op = [=](int r, int col, float v) { const float t = fmaxf(v, 0.f); hid[r * DFF + col] = (bf16)(pk2f(t * t, 0.f) & 0xffffu); };
          skinny_gemm<DMODEL>(lds, (const bf16*)(ws + WS_WUP), DFF / 16, bx, G, tid, lane, wave, op); }
        if (BOTH(6)) GRID_BAR();
    }
    if (IN(7)) {
        { pg8::Gemm g{(const pg8::bf16_t*)(ws + WS_XN), (const pg8::bf16_t*)(ws + WS_WUP), MROWS, DFF, DMODEL}; pg8::StaticOrder S; S.init(MROWS, DFF, G, bx);
          pg8::EpiUp E{(pg8::bf16_t*)(ws + WS_HB), ss1};
          pg8::gemm_phase<pg8::EpiUp, pg8::StaticOrder, true, true>(lds, g, S, E); }
        __syncthreads();
        { sk_fill_bf16<DFF>(lds, (const bf16*)(smp + SM_HID), tid); __syncthreads();
          float* h2s = (float*)(smp + SM_H2); const float* h1s = (const float*)(smp + SM_H1);
          auto op = [=](int r, int col, float v) { h2s[r * DMODEL + col] = h1s[r * DMODEL + col] + v; };
          skinny_gemm<DFF>(lds, (const bf16*)(ws + WS_WDOWN), DMODEL / 16, bx, G, tid, lane, wave, op); }
        if (BOTH(7)) GRID_BAR();
    }
    if (IN(8)) {
        { pg8::Gemm g{(const pg8::bf16_t*)(ws + WS_HB), (const pg8::bf16_t*)(ws + WS_WDOWN), MROWS, DMODEL, DFF}; pg8::StaticOrder S; S.init(MROWS, DMODEL, G, bx);
          pg8::EpiDown E{(float*)(ws + WS_H1), (pg8::bf16_t*)(ws + WS_XN)};
          pg8::gemm_phase<pg8::EpiDown, pg8::StaticOrder, true, true>(lds, g, S, E); }
        __syncthreads();
        { sk_fill_f32<PLE>(lds, args.in[I_PS], tid); __syncthreads();
          float* e0s = (float*)(smp + SM_E0);
          auto op = [=](int r, int col, float v) { e0s[r * DMODEL + col] = v; };
          skinny_gemm<PLE>(lds, (const bf16*)(ws + WS_WPLE), DMODEL / 16, bx, G, tid, lane, wave, op); }
        __syncthreads();
        { sk_fill_f32<DMODEL>(lds, (const float*)(smp + SM_H2), tid); __syncthreads();
          float* gs = (float*)(smp + SM_GATE);
          auto op = [=](int r, int col, float v) { gs[r * DMODEL + col] = v; };
          skinny_gemm<DMODEL>(lds, (const bf16*)(ws + WS_WGATE), DMODEL / 16, bx, G, tid, lane, wave, op); }
        if (BOTH(8)) GRID_BAR();
    }
    if (IN(9)) {
        { pg8::Gemm g{(const pg8::bf16_t*)(ws + WS_XN), (const pg8::bf16_t*)(ws + WS_WGATE), MROWS, DMODEL, DMODEL}; pg8::StaticOrder S; S.init(MROWS, DMODEL, G, bx);
          pg8::EpiGate E{(const float*)(ws + WS_H1), (const float*)(ws + WS_E0), sse, args.in[I_WPLEN], out + O_YP, ss3};
          pg8::gemm_phase<pg8::EpiGate, pg8::StaticOrder, true, true>(lds, g, S, E); }
        if (BOTH(9)) GRID_BAR();
    }
    if (IN(10)) {
        const int gw = vcu * NWAVES + wave, NGW = G * NWAVES;
        const GAS f32x4* gf = (const GAS f32x4*)args.in[I_GFIN] + lane;
        for (int m = gw; m < MROWS; m += NGW) {
            const float rstd = rsqrtf(ss3[m] * (1.f / DMODEL) + NORM_EPS);
            GAS f32x4* yr = (GAS f32x4*)(out + O_YP + (size_t)m * DMODEL) + lane;
#pragma unroll
            for (int j = 0; j < 8; ++j) { f32x4 v = yr[64 * j]; const f32x4 gv = gf[64 * j]; v.x *= rstd * gv.x; v.y *= rstd * gv.y; v.z *= rstd * gv.z; v.w *= rstd * gv.w; yr[64 * j] = v; }
        }
        if (bx == G - 1) {
            const int r = wave;
            const GAS f32x4* h2 = (const GAS f32x4*)(smp + SM_H2 + (size_t)r * DMODEL * 4) + lane; const GAS f32x4* e0 = (const GAS f32x4*)(smp + SM_E0 + (size_t)r * DMODEL * 4) + lane;
            const GAS f32x4* gt = (const GAS f32x4*)(smp + SM_GATE + (size_t)r * DMODEL * 4) + lane; const GAS f32x4* wn = (const GAS f32x4*)args.in[I_WPLEN] + lane;
            f32x4 ev[8]; float se = 0.f;
#pragma unroll
            for (int j = 0; j < 8; ++j) { ev[j] = e0[64 * j]; se += (ev[j].x * ev[j].x + ev[j].y * ev[j].y) + (ev[j].z * ev[j].z + ev[j].w * ev[j].w); }
            const float rstde = rsqrtf(wave_sum(se) * (1.f / DMODEL) + NORM_EPS);
            f32x4 h3[8]; float s3 = 0.f;
#pragma unroll
            for (int j = 0; j < 8; ++j) { const f32x4 hv = h2[64 * j], gv = gt[64 * j], wv = wn[64 * j]; f32x4 o;
                o.x = hv.x + ev[j].x * rstde * wv.x / (1.f + __expf(-gv.x)); o.y = hv.y + ev[j].y * rstde * wv.y / (1.f + __expf(-gv.y));
                o.z = hv.z + ev[j].z * rstde * wv.z / (1.f + __expf(-gv.z)); o.w = hv.w + ev[j].w * rstde * wv.w / (1.f + __expf(-gv.w));
                h3[j] = o; s3 += (o.x * o.x + o.y * o.y) + (o.z * o.z + o.w * o.w); }
            const float rstd = rsqrtf(wave_sum(s3) * (1.f / DMODEL) + NORM_EPS);
            GAS f32x4* yr = (GAS f32x4*)(out + O_YS + (size_t)r * DMODEL) + lane;
#pragma unroll
            for (int j = 0; j < 8; ++j) { const f32x4 gv = gf[64 * j]; f32x4 o = h3[j]; o.x *= rstd * gv.x; o.y *= rstd * gv.y; o.z *= rstd * gv.z; o.w *= rstd * gv.w; yr[64 * j] = o; }
        }
    }
#undef IN
#undef BOTH
}

extern "C" void kernel_launch(void* const* d_in, const int* in_sizes, int n_in, void* d_out, int out_size, void* d_ws, size_t ws_size, hipStream_t stream) {
    static int grid = 0;
    if (grid == 0) {
        if (n_in != 30 || out_size != (int)O_END || ws_size < WS_END) { fprintf(stderr, "kernel_launch: unexpected problem (n_in %d, out %d, ws %zu); nothing launched\n", n_in, out_size, ws_size); grid = -1; return; }
        int dev = 0, cus = 0, per_cu = 0;
        if (hipGetDevice(&dev) != hipSuccess || hipDeviceGetAttribute(&cus, hipDeviceAttributeMultiprocessorCount, dev) != hipSuccess) { grid = -1; return; }
        if (hipFuncSetAttribute((const void*)hymba_fwd, hipFuncAttributeMaxDynamicSharedMemorySize, LDS_BYTES) != hipSuccess) { fprintf(stderr, "kernel_launch: hipFuncSetAttribute failed\n"); grid = -1; return; }
        if (hipOccupancyMaxActiveBlocksPerMultiprocessor(&per_cu, (const void*)hymba_fwd, NTHREADS, LDS_BYTES) != hipSuccess || per_cu < 1) fprintf(stderr, "kernel_launch: note: occupancy query reports %d\n", per_cu);
        (void)hipGetLastError();
        grid = cus;
        if (grid > 256) grid = 256;
    }
    if (grid < 0) return;
    if (hipMemsetAsync((char*)d_ws + WS_CTL, 0, CTL_ZERO_BYTES, stream) != hipSuccess) return;
    Args a{};
    for (int i = 0; i < 30; ++i) a.in[i] = (const float*)d_in[i];
    a.out = (float*)d_out; a.ws = (unsigned char*)d_ws;
#if MK_SPLIT
    for (int p = 0; p < N_PHASES; ++p) { a.ph_lo = p; a.ph_hi = p + 1; hipLaunchKernelGGL(hymba_fwd, dim3(grid), dim3(NTHREADS), LDS_BYTES, stream, a); }
#else
    a.ph_lo = 0; a.ph_hi = N_PHASES;
    hipLaunchKernelGGL(hymba_fwd, dim3(grid), dim3(NTHREADS), LDS_BYTES, stream, a);
#endif
}
```

```cpp
#include <hip/hip_runtime.h>
#include <cstdio>
#include <cstdint>

#ifndef MK_SPLIT
#define MK_SPLIT 0
#endif

constexpr int MROWS = 8192, DMODEL = 2048, SEQ = 4096;
constexpr int NPROJ = 5648, NPAD = 5888;
constexpr int DFF = 8192, PLE = 256;
constexpr int C_Q = 0, C_K = 1024, C_V = 2048, C_Z = 3072, C_X = 4096, C_B = 5120, C_C = 5376, C_DT = 5632;
constexpr int XBC = 1536;
constexpr int DB = 8, PAST = 16384, PAGE = 128, NPAGES = 128;
constexpr float NORM_EPS = 1e-6f, SUBLN_EPS = 1e-5f;
constexpr float LOG2E = 1.4426950408889634f;
constexpr float QSCALE = 0.125f * LOG2E;
constexpr float LAM_INIT = 0.2f;

namespace pg8 {
#define PG8_LAS __attribute__((address_space(3)))
typedef unsigned short bf16_t;
typedef short bf16x8 __attribute__((ext_vector_type(8)));
typedef float f32x4 __attribute__((ext_vector_type(4)));
typedef unsigned u32x4 __attribute__((ext_vector_type(4)));
constexpr int BM = 256, BK = 64, HALF = 128, HTB = HALF * BK * 2  , STAGE_BYTES = 8 * HTB, NXCD = 8, WGM = 8;

__host__ __device__ __forceinline__ int lds_byte(int r, int c) { const int st = (r >> 4) * 2 + (c >> 5), rr = r & 15, cc = c & 31, ob = rr * 64 + cc * 2; return st * 1024 + (ob ^ (((ob >> 9) & 1) << 5)); }
__host__ __device__ __forceinline__ void stage_rc(int b, int& R, int& C) { const int st = b / 1024, sb = b % 1024, swz = sb ^ (((sb >> 9) & 1) << 5); R = (st >> 1) * 16 + swz / 64; C = (st & 1) * 32 + (swz % 64) / 2; }
__host__ __device__ __forceinline__ int perm32(int rho) { const int n = rho >> 4, i = rho & 15; return 8 * (i >> 2) + 4 * n + (i & 3); }

struct Unit { int pm, pn; };
struct Gemm { const bf16_t* A; const bf16_t* Bt; int M, N, K; };

struct StaticOrder {
    int nM, nN, nwg, G, c;
    __host__ __device__ void init(int M, int N, int G_, int c_) { nM = M / BM; nN = N / BM; nwg = nM * nN; G = G_; c = c_; }
    __host__ __device__ bool next(int i, Unit& u) const {
        const long L = (long)i * G + c; if (L >= nwg) return false;
        int wgid = (int)L; { const int q = nwg / NXCD, r = nwg % NXCD, xcd = wgid % NXCD, off = wgid / NXCD; wgid = (xcd < r ? xcd * (q + 1) : r * (q + 1) + (xcd - r) * q) + off; }
        const int nig = WGM * nN, gid = wgid / nig, fm = gid * WGM, gsz = (nM - fm) < WGM ? (nM - fm) : WGM;
        u.pm = fm + ((wgid % nig) % gsz); u.pn = (wgid % nig) / gsz; return true;
    }
    __device__ __forceinline__ void a_ready(const Unit&) const {}
    __device__ __forceinline__ void done(const Unit&) const {}
};

__device__ __forceinline__ unsigned cvt_pk_bf16(float lo, float hi) { unsigned r; asm volatile("v_cvt_pk_bf16_f32 %0, %1, %2" : "=v"(r) : "v"(lo), "v"(hi)); return r; }
typedef float f32x2 __attribute__((ext_vector_type(2)));
typedef unsigned u32x2 __attribute__((ext_vector_type(2)));
__device__ __forceinline__ u32x4 pack8(f32x4 a, f32x4 b) { u32x4 w; w.x = cvt_pk_bf16(a[0], a[1]); w.y = cvt_pk_bf16(a[2], a[3]); w.z = cvt_pk_bf16(b[0], b[1]); w.w = cvt_pk_bf16(b[2], b[3]); return w; }
__device__ __forceinline__ float sumsq8(f32x4 a, f32x4 b) { return (a[0] * a[0] + a[1] * a[1]) + (a[2] * a[2] + a[3] * a[3]) + (b[0] * b[0] + b[1] * b[1]) + (b[2] * b[2] + b[3] * b[3]); }

struct EpiProj {
    static constexpr bool PERM = true, AFTER_DRAIN = false;
    bf16_t* proj; float* kout; float* vout; float* convout; float* dt;
    __device__ __forceinline__ void operator()(const f32x4 (&acc)[2][2][4][2], const Unit& u, int wr, int wc, int fr, int fq) const {
        const int pn = u.pn, row0 = u.pm * BM + wr * 64 + fr, colw = wc * 32 + 8 * fq;
        if (pn < 22) {
            const float sc = pn < 4 ? QSCALE : 1.f;
#pragma unroll
            for (int ai = 0; ai < 2; ++ai)
#pragma unroll
                for (int m = 0; m < 4; ++m) { const int row = row0 + ai * HALF + m * 16;
#pragma unroll
                    for (int bj = 0; bj < 2; ++bj) { const int col = pn * BM + bj * HALF + colw;
                        const f32x4 v0 = acc[ai][bj][m][0] * sc, v1 = acc[ai][bj][m][1] * sc;
                        *(u32x4*)(proj + (size_t)row * NPAD + col) = pack8(v0, v1);
                        if (pn >= 4 && pn < 8) { float* o = kout + (size_t)row * 1024 + (col - C_K); *(f32x4*)o = v0; *(f32x4*)(o + 4) = v1; }
                        else if (pn >= 8 && pn < 12) { float* o = vout + (size_t)row * 1024 + (col - C_V); *(f32x4*)o = v0; *(f32x4*)(o + 4) = v1; }
                        else if (pn >= 16) { const int t = row & (SEQ - 1); if (t >= SEQ - 3) { float* o = convout + ((size_t)(row >> 12) * 3 + (t - (SEQ - 3))) * XBC + (col - C_X); *(f32x4*)o = v0; *(f32x4*)(o + 4) = v1; } }
                    } }
        } else {
            if (wc == 0 && fq < 2) {
#pragma unroll
                for (int ai = 0; ai < 2; ++ai)
#pragma unroll
                    for (int m = 0; m < 4; ++m) { const int row = row0 + ai * HALF + m * 16; float* o = dt + (size_t)row * 16 + 8 * fq; *(f32x4*)o = acc[ai][0][m][0]; *(f32x4*)(o + 4) = acc[ai][0][m][1]; }
            }
        }
    }
};
struct EpiOut {
    static constexpr bool PERM = true, AFTER_DRAIN = false;
    const float* xres; float* h1; bf16_t* a2; const float* g; float* ss;
    __device__ __forceinline__ void operator()(const f32x4 (&acc)[2][2][4][2], const Unit& u, int wr, int wc, int fr, int fq) const {
        const int row0 = u.pm * BM + wr * 64 + fr, colw = u.pn * BM + wc * 32 + 8 * fq;
#pragma unroll
        for (int ai = 0; ai < 2; ++ai)
#pragma unroll
            for (int m = 0; m < 4; ++m) { const int row = row0 + ai * HALF + m * 16; float s = 0.f;
#pragma unroll
                for (int bj = 0; bj < 2; ++bj) { const int col = colw + bj * HALF; const size_t off = (size_t)row * DMODEL + col;
                    const f32x4 h0 = *(const f32x4*)(xres + off) + acc[ai][bj][m][0], h1v = *(const f32x4*)(xres + off + 4) + acc[ai][bj][m][1];
                    *(f32x4*)(h1 + off) = h0; *(f32x4*)(h1 + off + 4) = h1v;
                    const f32x4 g0 = *(const f32x4*)(g + col), g1 = *(const f32x4*)(g + col + 4);
                    *(u32x4*)(a2 + off) = pack8(h0 * g0, h1v * g1);
                    s += sumsq8(h0, h1v); }
                s += __shfl_xor(s, 16); s += __shfl_xor(s, 32);
                if (fq == 0) atomicAdd(ss + row, s); }
    }
};
struct EpiUp {
    static constexpr bool PERM = true, AFTER_DRAIN = false;
    bf16_t* hb; const float* ss;
    __device__ __forceinline__ void operator()(const f32x4 (&acc)[2][2][4][2], const Unit& u, int wr, int wc, int fr, int fq) const {
        const int row0 = u.pm * BM + wr * 64 + fr, colw = u.pn * BM + wc * 32 + 8 * fq;
#pragma unroll
        for (int ai = 0; ai < 2; ++ai)
#pragma unroll
            for (int m = 0; m < 4; ++m) { const int row = row0 + ai * HALF + m * 16; const float rstd = rsqrtf(ss[row] * (1.f / DMODEL) + NORM_EPS);
#pragma unroll
                for (int bj = 0; bj < 2; ++bj) { const int col = colw + bj * HALF;
                    f32x4 v0 = acc[ai][bj][m][0] * rstd, v1 = acc[ai][bj][m][1] * rstd;
#pragma unroll
                    for (int e = 0; e < 4; ++e) { const float a = fmaxf(v0[e], 0.f), b = fmaxf(v1[e], 0.f); v0[e] = a * a; v1[e] = b * b; }
                    *(u32x4*)(hb + (size_t)row * DFF + col) = pack8(v0, v1); } }
    }
};
struct EpiDown {
    static constexpr bool PERM = true, AFTER_DRAIN = false;
    float* h; bf16_t* hb16;
    __device__ __forceinline__ void operator()(const f32x4 (&acc)[2][2][4][2], const Unit& u, int wr, int wc, int fr, int fq) const {
        const int row0 = u.pm * BM + wr * 64 + fr, colw = u.pn * BM + wc * 32 + 8 * fq;
#pragma unroll
        for (int ai = 0; ai < 2; ++ai)
#pragma unroll
            for (int m = 0; m < 4; ++m) { const int row = row0 + ai * HALF + m * 16;
#pragma unroll
                for (int bj = 0; bj < 2; ++bj) { const size_t off = (size_t)row * DMODEL + colw + bj * HALF;
                    const f32x4 h0 = *(const f32x4*)(h + off) + acc[ai][bj][m][0], h1v = *(const f32x4*)(h + off + 4) + acc[ai][bj][m][1];
                    *(f32x4*)(h + off) = h0; *(f32x4*)(h + off + 4) = h1v; *(u32x4*)(hb16 + off) = pack8(h0, h1v); } }
    }
};
struct EpiPle {
    static constexpr bool PERM = true, AFTER_DRAIN = false;
    float* e0; float* sse;
    __device__ __forceinline__ void operator()(const f32x4 (&acc)[2][2][4][2], const Unit& u, int wr, int wc, int fr, int fq) const {
        const int row0 = u.pm * BM + wr * 64 + fr, colw = u.pn * BM + wc * 32 + 8 * fq;
#pragma unroll
        for (int ai = 0; ai < 2; ++ai)
#pragma unroll
            for (int m = 0; m < 4; ++m) { const int row = row0 + ai * HALF + m * 16; float s = 0.f;
#pragma unroll
                for (int bj = 0; bj < 2; ++bj) { const size_t off = (size_t)row * DMODEL + colw + bj * HALF;
                    *(f32x4*)(e0 + off) = acc[ai][bj][m][0]; *(f32x4*)(e0 + off + 4) = acc[ai][bj][m][1]; s += sumsq8(acc[ai][bj][m][0], acc[ai][bj][m][1]); }
                s += __shfl_xor(s, 16); s += __shfl_xor(s, 32);
                if (fq == 0) atomicAdd(sse + row, s); }
    }
};
struct EpiGate {
    static constexpr bool PERM = true, AFTER_DRAIN = false;
    const float* h2; const float* e0; const float* sse; const float* wn; float* out; float* ss3;
    __device__ __forceinline__ void operator()(const f32x4 (&acc)[2][2][4][2], const Unit& u, int wr, int wc, int fr, int fq) const {
        const int row0 = u.pm * BM + wr * 64 + fr, colw = u.pn * BM + wc * 32 + 8 * fq;
#pragma unroll
        for (int ai = 0; ai < 2; ++ai)
#pragma unroll
            for (int m = 0; m < 4; ++m) { const int row = row0 + ai * HALF + m * 16; const float rstde = rsqrtf(sse[row] * (1.f / DMODEL) + NORM_EPS); float s = 0.f;
#pragma unroll
                for (int bj = 0; bj < 2; ++bj) { const int col = colw + bj * HALF; const size_t off = (size_t)row * DMODEL + col;
#pragma unroll
                    for (int n = 0; n < 2; ++n) { const f32x4 a = acc[ai][bj][m][n], hv = *(const f32x4*)(h2 + off + 4 * n), ev = *(const f32x4*)(e0 + off + 4 * n), wv = *(const f32x4*)(wn + col + 4 * n); f32x4 o;
#pragma unroll
                        for (int e = 0; e < 4; ++e) { const float sg = 1.f / (1.f + __expf(-a[e])); o[e] = hv[e] + ev[e] * rstde * wv[e] * sg; s += o[e] * o[e]; }
                        *(f32x4*)(out + off + 4 * n) = o; } }
                s += __shfl_xor(s, 16); s += __shfl_xor(s, 32);
                if (fq == 0) atomicAdd(ss3 + row, s); }
    }
};

template <class Epi, class Sched, bool ALIGN_EPI = false, bool SP2 = false>
__device__ __forceinline__ void gemm_phase(PG8_LAS unsigned char* lds, const Gemm g, const Sched& S, const Epi& E) {
    const int tid = threadIdx.x, wid = __builtin_amdgcn_readfirstlane(tid >> 6), lane = tid & 63, wr = wid >> 2, wc = wid & 3, fr = lane & 15, fq = lane >> 4;
    const int K = g.K, nt = K / BK;
    unsigned voffA[2], voffB[2];
#pragma unroll
    for (int i = 0; i < 2; ++i) { int R, C; stage_rc(tid * 16 + i * 8192, R, C); const int Rb = Epi::PERM ? ((R & ~31) + perm32(R & 31)) : R;
        voffA[i] = (unsigned)(R * K + C) * 2u; voffB[i] = (unsigned)(Rb * K + C) * 2u; }
    const size_t kstep = (size_t)(BK * 2);
    const size_t hstep = (size_t)HALF * K * 2;
    const size_t tstep = 2 * hstep;
    const unsigned ldsw = (unsigned)wid * 1024u;
    const int aoff = lds_byte(wr * 64 + fr, fq * 8), boff = lds_byte(wc * 32 + fr, fq * 8);
#define PG8_SA(b, h) (((b) * 2 + (h)) * HTB)
#define PG8_SB(b, h) ((4 + (b) * 2 + (h)) * HTB)
#define PG8_STAGE(bufoff, gbase, voff) do { _Pragma("unroll") for (int _i = 0; _i < 2; ++_i) \
        __builtin_amdgcn_global_load_lds((const unsigned*)((const char*)(gbase) + (voff)[_i]), (PG8_LAS unsigned*)(lds + (bufoff) + ldsw + _i * 8192), 16, 0, 0); } while (0)
#define PG8_LDA(dst, b, h) do { _Pragma("unroll") for (int m = 0; m < 4; ++m) _Pragma("unroll") for (int k = 0; k < 2; ++k) dst[m][k] = *(const PG8_LAS bf16x8*)(lds + PG8_SA(b, h) + aoff + m * 2048 + k * 1024); } while (0)
#define PG8_LDB(dst, b, h) do { _Pragma("unroll") for (int n = 0; n < 2; ++n) _Pragma("unroll") for (int k = 0; k < 2; ++k) dst[n][k] = *(const PG8_LAS bf16x8*)(lds + PG8_SB(b, h) + boff + n * 2048 + k * 1024); } while (0)
#define PG8_MMA(ai, bj, At, Bt) do { __builtin_amdgcn_s_setprio(1); _Pragma("unroll") for (int m = 0; m < 4; ++m) _Pragma("unroll") for (int n = 0; n < 2; ++n) _Pragma("unroll") for (int k = 0; k < 2; ++k) \
        acc[ai][bj][m][n] = __builtin_amdgcn_mfma_f32_16x16x32_bf16(Bt[n][k], At[m][k], acc[ai][bj][m][n], 0, 0, 0); __builtin_amdgcn_s_setprio(0); } while (0)
#define PG8_WAIT_V(n) asm volatile("s_waitcnt vmcnt(" #n ")" ::: "memory")
#define PG8_WAIT_L(n) asm volatile("s_waitcnt lgkmcnt(" #n ")" ::: "memory")
#define PG8_BAR __builtin_amdgcn_s_barrier()
#define PG8_SCHED __builtin_amdgcn_sched_barrier(0)
    Unit cur, nxt; int ui = 0;
    if (!S.next(0, cur)) return;
    f32x4 acc[2][2][4][2];
#pragma unroll
    for (int a = 0; a < 2; ++a)
#pragma unroll
        for (int b = 0; b < 2; ++b)
#pragma unroll
            for (int m = 0; m < 4; ++m)
#pragma unroll
                for (int n = 0; n < 2; ++n) acc[a][b][m][n] = (f32x4){0.f, 0.f, 0.f, 0.f};
    bf16x8 At[4][2], B0[2][2], B1[2][2];
    const char* cA = (const char*)g.A + (size_t)cur.pm * tstep; const char* cB = (const char*)g.Bt + (size_t)cur.pn * tstep;
    S.a_ready(cur);
    if constexpr (SP2) {
        PG8_STAGE(PG8_SB(0, 0), cB, voffB); PG8_STAGE(PG8_SB(0, 1), cB + hstep, voffB); PG8_STAGE(PG8_SA(0, 0), cA, voffA); PG8_STAGE(PG8_SA(0, 1), cA + hstep, voffA);
        if (wr == 1) PG8_BAR;
        PG8_WAIT_V(2); PG8_BAR;
        PG8_STAGE(PG8_SB(1, 0), cB + kstep, voffB); PG8_STAGE(PG8_SA(1, 0), cA + kstep, voffA); PG8_STAGE(PG8_SB(1, 1), cB + hstep + kstep, voffB);
        PG8_WAIT_V(6); PG8_BAR;
    } else {
        PG8_STAGE(PG8_SB(0, 0), cB, voffB); PG8_STAGE(PG8_SA(0, 0), cA, voffA); PG8_STAGE(PG8_SB(0, 1), cB + hstep, voffB); PG8_STAGE(PG8_SA(0, 1), cA + hstep, voffA);
        if (wr == 1) PG8_BAR;
        PG8_WAIT_V(4); PG8_BAR;
        PG8_STAGE(PG8_SB(1, 0), cB + kstep, voffB); PG8_STAGE(PG8_SA(1, 0), cA + kstep, voffA); PG8_STAGE(PG8_SB(1, 1), cB + hstep + kstep, voffB);
        PG8_WAIT_V(6); PG8_BAR;
    }
    for (;;) {
        const bool has_next = S.next(ui + 1, nxt);
        const char* nA = has_next ? (const char*)g.A + (size_t)nxt.pm * tstep : cA; const char* nB = has_next ? (const char*)g.Bt + (size_t)nxt.pn * tstep : cB;
        _Pragma("nounroll") for (int t = 0; t < nt; t += 2) {
            const bool last = (t == nt - 2);
            const char* a1 = cA + (size_t)(t + 1) * kstep;
            const char* a2 = last ? nA : cA + (size_t)(t + 2) * kstep; const char* b2 = last ? nB : cB + (size_t)(t + 2) * kstep;
            const char* a3 = a2 + kstep; const char* b3 = b2 + kstep;
            if (last && has_next) S.a_ready(nxt);
            if constexpr (SP2) {
            PG8_LDB(B0, 0, 0); PG8_LDB(B1, 0, 1); PG8_SCHED; PG8_LDA(At, 0, 0); PG8_STAGE(PG8_SA(1, 1), a1 + hstep, voffA);
            PG8_WAIT_V(8); PG8_WAIT_L(0); PG8_BAR; PG8_MMA(0, 0, At, B0); PG8_MMA(0, 1, At, B1); PG8_BAR; PG8_SCHED;
            PG8_LDA(At, 0, 1); PG8_STAGE(PG8_SB(0, 0), b2, voffB); PG8_STAGE(PG8_SB(0, 1), b2 + hstep, voffB); PG8_STAGE(PG8_SA(0, 0), a2, voffA);
            PG8_WAIT_V(8); PG8_WAIT_L(0); PG8_BAR; PG8_MMA(1, 0, At, B0); PG8_MMA(1, 1, At, B1); PG8_BAR; PG8_SCHED;
            PG8_LDB(B0, 1, 0); PG8_LDB(B1, 1, 1); PG8_SCHED; PG8_LDA(At, 1, 0); PG8_STAGE(PG8_SA(0, 1), a2 + hstep, voffA);
            PG8_WAIT_V(8); PG8_WAIT_L(0); PG8_BAR; PG8_MMA(0, 0, At, B0); PG8_MMA(0, 1, At, B1); PG8_BAR; PG8_SCHED;
            PG8_LDA(At, 1, 1); PG8_STAGE(PG8_SB(1, 0), b3, voffB); PG8_STAGE(PG8_SB(1, 1), b3 + hstep, voffB); PG8_STAGE(PG8_SA(1, 0), a3, voffA);
            PG8_WAIT_V(8); PG8_WAIT_L(0); PG8_BAR; PG8_MMA(1, 0, At, B0); PG8_MMA(1, 1, At, B1); PG8_BAR; PG8_SCHED;
            } else {
            PG8_LDB(B0, 0, 0); PG8_SCHED; PG8_LDA(At, 0, 0); PG8_STAGE(PG8_SA(1, 1), a1 + hstep, voffA);
            PG8_WAIT_L(8); PG8_BAR; PG8_WAIT_L(0); PG8_MMA(0, 0, At, B0); PG8_BAR; PG8_SCHED;
            PG8_LDB(B1, 0, 1); PG8_STAGE(PG8_SB(0, 0), b2, voffB);
            PG8_BAR; PG8_WAIT_L(0); PG8_MMA(0, 1, At, B1); PG8_BAR;
            PG8_LDA(At, 0, 1); PG8_STAGE(PG8_SA(0, 0), a2, voffA);
            PG8_BAR; PG8_WAIT_L(0); PG8_MMA(1, 0, At, B0); PG8_BAR; PG8_SCHED;
            PG8_STAGE(PG8_SB(0, 1), b2 + hstep, voffB);
            PG8_WAIT_V(6); PG8_BAR; PG8_MMA(1, 1, At, B1); PG8_BAR;
            PG8_LDB(B0, 1, 0); PG8_SCHED; PG8_LDA(At, 1, 0); PG8_STAGE(PG8_SA(0, 1), a2 + hstep, voffA);
            PG8_WAIT_L(8); PG8_BAR; PG8_WAIT_L(0); PG8_MMA(0, 0, At, B0); PG8_BAR; PG8_SCHED;
            PG8_LDB(B1, 1, 1); PG8_STAGE(PG8_SB(1, 0), b3, voffB);
            PG8_BAR; PG8_WAIT_L(0); PG8_MMA(0, 1, At, B1); PG8_BAR;
            PG8_LDA(At, 1, 1); PG8_STAGE(PG8_SA(1, 0), a3, voffA);
            PG8_BAR; PG8_WAIT_L(0); PG8_MMA(1, 0, At, B0); PG8_BAR; PG8_SCHED;
            PG8_STAGE(PG8_SB(1, 1), b3 + hstep, voffB);
            PG8_WAIT_V(6); PG8_BAR; PG8_MMA(1, 1, At, B1); PG8_BAR;
            }
        }
        if constexpr (ALIGN_EPI) { if (wr == 0) PG8_BAR; }
        if constexpr (!Epi::AFTER_DRAIN) { E(acc, cur, wr, wc, fr, fq); S.done(cur); }
        if (!has_next) break;
#pragma unroll
        for (int a = 0; a < 2; ++a)
#pragma unroll
            for (int b = 0; b < 2; ++b)
#pragma unroll
                for (int m = 0; m < 4; ++m)
#pragma unroll
                    for (int n = 0; n < 2; ++n) acc[a][b][m][n] = (f32x4){0.f, 0.f, 0.f, 0.f};
        cur = nxt; cA = nA; cB = nB; ++ui;
        if constexpr (ALIGN_EPI) { if (wr == 1) PG8_BAR; }
    }
    PG8_WAIT_V(0);
    if constexpr (!ALIGN_EPI) { if (wr == 0) PG8_BAR; }
    PG8_BAR;
    if constexpr (Epi::AFTER_DRAIN) { E.fused(acc, cur, wr, wc, fr, fq, lds, wid, lane); S.done(cur); }
#undef PG8_SA
#undef PG8_SB
#undef PG8_STAGE
#undef PG8_LDA
#undef PG8_LDB
#undef PG8_MMA
#undef PG8_WAIT_V
#undef PG8_WAIT_L
#undef PG8_BAR
#undef PG8_SCHED
}
}
#define GAS __attribute__((address_space(1)))
#define LAS __attribute__((address_space(3)))
typedef unsigned short bf16;
typedef unsigned v4u __attribute__((ext_vector_type(4)));
typedef float f32x4 __attribute__((ext_vector_type(4)));
typedef short bf16x8 __attribute__((ext_vector_type(8)));
typedef GAS unsigned gu32;
typedef GAS unsigned long long gu64;
#define RLX_AGENT __ATOMIC_RELAXED, __HIP_MEMORY_SCOPE_AGENT
#define LDS_WAIT() asm volatile("s_waitcnt lgkmcnt(0)" ::: "memory")
#define VM_WAIT() asm volatile("s_waitcnt vmcnt(0)" ::: "memory")
__device__ __forceinline__ unsigned long long rt() { return __builtin_amdgcn_s_memrealtime(); }
__device__ __forceinline__ unsigned f2bf(float f) { unsigned u = __builtin_bit_cast(unsigned, f); return (u + 0x7fffu + ((u >> 16) & 1u)) >> 16; }
__device__ __forceinline__ unsigned pk2(float lo, float hi) { return f2bf(lo) | (f2bf(hi) << 16); }

#define XB_TMO      128
#define XB_XCNT(j)  (256  + 64 * (j))
#define XB_XSUB(j)  (1280 + 64 * (j))
#define XB_XGEN(j)  (2304 + 64 * (j))
#define XB_TOP      3328
#define XB_TOPGEN   3392
#define XCD_BAR_WORDS 3456
#define XB_SPIN_CAP (1u << 18)

__device__ __forceinline__ unsigned xb_ld(unsigned* p)              { return __hip_atomic_load(p, __ATOMIC_RELAXED, __HIP_MEMORY_SCOPE_AGENT); }
__device__ __forceinline__ unsigned xb_add(unsigned* p, unsigned v) { return __hip_atomic_fetch_add(p, v, __ATOMIC_RELAXED, __HIP_MEMORY_SCOPE_AGENT); }
__device__ __forceinline__ unsigned xb_xcc_id() { return (unsigned)__builtin_amdgcn_s_getreg((3 << 11) | 20) & 0xFu; }
#define XB_SPIN(cond, bar) do { unsigned _sp = 0; while (cond) { __builtin_amdgcn_s_sleep(1); \
    if ((++_sp & 255u) == 0u) { if (xb_ld(&(bar)[XB_TMO])) break; if (_sp > XB_SPIN_CAP) { atomicAdd(&(bar)[XB_TMO], 1u); break; } } } } while (0)

struct XcdBarrier {
    unsigned* bar; unsigned x;
    volatile LAS unsigned* st;
};

__device__ __forceinline__ XcdBarrier xcd_barrier_post(unsigned* bar, volatile LAS unsigned* st) {
    XcdBarrier b; b.bar = bar; b.x = xb_xcc_id(); b.st = st;
    if (threadIdx.x == 0) (void)xb_add(&bar[XB_XCNT(b.x)], 1u);
    return b;
}
__device__ __forceinline__ void xcd_barrier_complete(unsigned* bar, unsigned x, unsigned& nloc, unsigned& nx) {
    const unsigned G = gridDim.x * gridDim.y * gridDim.z;
    unsigned sum, cnt, mine, sp = 0u;
    for (;;) {
        sum = 0u; cnt = 0u; mine = 0u;
#pragma unroll
        for (unsigned j = 0; j < 16; ++j) { const unsigned c = xb_ld(&bar[XB_XCNT(j)]); sum += c; cnt += (c > 0u) ? 1u : 0u; mine = (j == x) ? c : mine; }
        if (sum == G) break;
        __builtin_amdgcn_s_sleep(1);
        if ((++sp & 255u) == 0u) { if (xb_ld(&bar[XB_TMO])) break; if (sp > XB_SPIN_CAP) { atomicAdd(&bar[XB_TMO], 1u); break; } }
    }
    nloc = mine > 0u ? mine : 1u; nx = cnt > 0u ? cnt : 1u;
}

__device__ __forceinline__ void xcd_barrier(const XcdBarrier& b) {
    asm volatile("s_waitcnt vmcnt(0)" ::: "memory");
    __syncthreads();
    if (threadIdx.x == 0) {
        unsigned* bar = b.bar;
        __builtin_amdgcn_s_waitcnt(0);
        unsigned nloc = b.st[0], nx = b.st[1];
        if (nloc == 0u) { xcd_barrier_complete(bar, b.x, nloc, nx); b.st[0] = nloc; b.st[1] = nx; }
        const unsigned old = xb_add(&bar[XB_XSUB(b.x)], 1u);
        const unsigned gen = old / nloc;
        if (old + 1u == (gen + 1u) * nloc) {
            __builtin_amdgcn_fence(__ATOMIC_RELEASE, "agent");
            asm volatile("s_waitcnt vmcnt(0)" ::: "memory");
            const unsigned og = xb_add(&bar[XB_TOP], 1u);
            const unsigned tg = og / nx;
            if (og + 1u == (tg + 1u) * nx) xb_add(&bar[XB_TOPGEN], 1u);
            else XB_SPIN(xb_ld(&bar[XB_TOPGEN]) == tg, bar);
            __builtin_amdgcn_fence(__ATOMIC_ACQUIRE, "agent");
            xb_add(&bar[XB_XGEN(b.x)], 1u);
            asm volatile("s_waitcnt vmcnt(0)" ::: "memory");
        } else {
            XB_SPIN(xb_ld(&bar[XB_XGEN(b.x)]) == gen, bar);
            __builtin_amdgcn_fence(__ATOMIC_ACQUIRE, "agent");
            asm volatile("s_waitcnt vmcnt(0)" ::: "memory");
        }
    }
    __syncthreads();
}

constexpr size_t MiB = 1u << 20;
constexpr size_t WS_CTL = 0, CTL_ZERO_BYTES = 1 * MiB;
constexpr size_t WS_WIN = 2 * MiB, WS_WOUT = 26 * MiB, WS_WUP = 34 * MiB, WS_WDOWN = 66 * MiB, WS_WPLE = 98 * MiB, WS_WGATE = 100 * MiB;
constexpr size_t WS_XN = 108 * MiB;
constexpr size_t WS_PROJ = 140 * MiB;
constexpr size_t WS_XA = 232 * MiB;
constexpr size_t WS_MIX = 256 * MiB;
constexpr size_t WS_H1 = 288 * MiB;
constexpr size_t WS_HB = 352 * MiB;
constexpr size_t WS_STATES = 480 * MiB;
constexpr size_t WS_SIN = 512 * MiB;
constexpr size_t WS_E0 = 528 * MiB;
constexpr size_t WS_PB = 592 * MiB;
constexpr size_t WS_DT = 596 * MiB;
constexpr size_t WS_DTV = 597 * MiB;
constexpr size_t WS_ACS = 598 * MiB;
constexpr size_t WS_SMP = 600 * MiB;
constexpr size_t WS_PART = 604 * MiB;
constexpr size_t WS_END = 624 * MiB;
constexpr size_t SM_PROJ = 0;
constexpr size_t SM_MIX = 256 * 1024;
constexpr size_t SM_H1 = 320 * 1024;
constexpr size_t SM_HID = 384 * 1024;
constexpr size_t SM_H2 = 512 * 1024;
constexpr size_t SM_E0 = 576 * 1024;
constexpr size_t SM_GATE = 640 * 1024;
constexpr int SPROJ_LD = 5664;
constexpr int CW_TMO = 0, CW_CODE = 1, CW_BAR = 4096;
constexpr int CW_SS1 = 16384, CW_SSE = 16384 + 8192, CW_SS3 = 16384 + 16384;
constexpr size_t O_YP = 0, O_YS = 16777216, O_KP = 16793600, O_VP = 25182208, O_SP = 33570816, O_CP = 33832960, O_KS = 33842176, O_VS = 33850368, O_SS = 33858560, O_CS = 34907136, O_END = 34944000;
constexpr int LDS_BYTES = 147456, MISC_OFF = LDS_BYTES - 256;
constexpr int NWAVES = 8, NTHREADS = 512;

struct Args {
    const float* in[30];
    float* out; unsigned char* ws;
    int ph_lo, ph_hi;
};
enum { I_XP = 0, I_XS, I_PP, I_PS, I_CK, I_CV, I_PT, I_SSM, I_SCONV, I_GMIX, I_WIN, I_LQ1, I_LK1, I_LQ2, I_LK2, I_WSUB, I_CONVW, I_CONVB, I_DTB, I_ALOG, I_DSKIP, I_WSSMN, I_WOUT, I_GFFN, I_WUP, I_WDOWN, I_WPLE, I_WPLEN, I_WGATE, I_GFIN };

__device__ __forceinline__ float wave_sum(float v) {
#pragma unroll
    for (int o = 1; o < 64; o <<= 1) v += __shfl_xor(v, o);
    return v;
}
typedef float f32x2_t __attribute__((ext_vector_type(2))); typedef __bf16 bf16x2_t __attribute__((ext_vector_type(2)));
__device__ __forceinline__ unsigned cvtpk_s(float lo, float hi) { f32x2_t v = {lo, hi}; bf16x2_t b = __builtin_convertvector(v, bf16x2_t); return __builtin_bit_cast(unsigned, b); }
__device__ __forceinline__ unsigned pk2f(float lo, float hi) { return cvtpk_s(lo, hi); }
typedef short v4i16_t __attribute__((ext_vector_type(4)));
__device__ __forceinline__ float bf2f(unsigned short h) { return __uint_as_float((unsigned)h << 16); }
__device__ __forceinline__ float bflo(unsigned w) { return __uint_as_float(w << 16); }
__device__ __forceinline__ float bfhi(unsigned w) { return __uint_as_float(w & 0xffff0000u); }

__device__ __forceinline__ void p0_transpose_item(const float* W, int K, int N, int nblk, bf16* WT, LAS float* scr, int item, int lane) {
    const int kb = item / nblk, nb = item % nblk, k0 = 64 * kb, n0 = 32 * nb;
    const bool ok = (n0 + (lane & 31)) < N;
#pragma unroll 8
    for (int i = 0; i < 32; ++i) { const int kk = 2 * i + (lane >> 5); scr[kk * 33 + (lane & 31)] = ok ? W[(size_t)(k0 + kk) * N + n0 + (lane & 31)] : 0.f; }
    LDS_WAIT(); asm volatile("" ::: "memory");
    const int c = lane & 7;
#pragma unroll
    for (int j = 0; j < 4; ++j) { const int n = (lane >> 3) + 8 * j; const LAS float* s = scr + (8 * c) * 33 + n;
        v4u o; o.x = pk2f(s[0 * 33], s[1 * 33]); o.y = pk2f(s[2 * 33], s[3 * 33]); o.z = pk2f(s[4 * 33], s[5 * 33]); o.w = pk2f(s[6 * 33], s[7 * 33]);
        *(GAS v4u*)(WT + (size_t)(n0 + n) * K + k0 + 8 * c) = o; }
    LDS_WAIT(); asm volatile("" ::: "memory");
}
__device__ __forceinline__ void rms_row_to_bf16(const float* xrow, const float* g, bf16* orow, int lane) {
    const GAS f32x4* xr = (const GAS f32x4*)xrow + lane; const GAS f32x4* gr = (const GAS f32x4*)g + lane;
    f32x4 v[8]; float s = 0.f;
#pragma unroll
    for (int j = 0; j < 8; ++j) { v[j] = xr[64 * j]; s += (v[j].x * v[j].x + v[j].y * v[j].y) + (v[j].z * v[j].z + v[j].w * v[j].w); }
    const float rstd = rsqrtf(wave_sum(s) * (1.f / DMODEL) + NORM_EPS);
    GAS unsigned long long* o8 = (GAS unsigned long long*)orow + lane;
#pragma unroll
    for (int j = 0; j < 8; ++j) { const f32x4 gv = gr[64 * j]; o8[64 * j] = (unsigned long long)pk2f(v[j].x * rstd * gv.x, v[j].y * rstd * gv.y) | ((unsigned long long)pk2f(v[j].z * rstd * gv.z, v[j].w * rstd * gv.w) << 32); }
}
__device__ __forceinline__ void phase0_prologue(const Args& a, LAS unsigned char* lds, int tid, int lane, int wave, int vcu, int G) {
    LAS float* scr = (LAS float*)(lds + wave * 16384);
    const int gw = vcu * NWAVES + wave, NGW = G * NWAVES;
    unsigned char* ws = a.ws;
    constexpr int NB_IN = (NPROJ + 31) / 32;
    constexpr int I_IN = (DMODEL / 64) * NB_IN, I_OUT = (DMODEL / 64) * (DMODEL / 32), I_UP = (DMODEL / 64) * (DFF / 32), I_DN = (DFF / 64) * (DMODEL / 32), I_PL = (PLE / 64) * (DMODEL / 32), I_GT = I_OUT;
    constexpr int NITEMS = I_IN + I_OUT + I_UP + I_DN + I_PL + I_GT;
    for (int it = gw; it < NITEMS; it += NGW) {
        int r = it;
        if (r < I_IN) { p0_transpose_item(a.in[I_WIN], DMODEL, NPROJ, NB_IN, (bf16*)(ws + WS_WIN), scr, r, lane); continue; } r -= I_IN;
        if (r < I_OUT) { p0_transpose_item(a.in[I_WOUT], DMODEL, DMODEL, DMODEL / 32, (bf16*)(ws + WS_WOUT), scr, r, lane); continue; } r -= I_OUT;
        if (r < I_UP) { p0_transpose_item(a.in[I_WUP], DMODEL, DFF, DFF / 32, (bf16*)(ws + WS_WUP), scr, r, lane); continue; } r -= I_UP;
        if (r < I_DN) { p0_transpose_item(a.in[I_WDOWN], DFF, DMODEL, DMODEL / 32, (bf16*)(ws + WS_WDOWN), scr, r, lane); continue; } r -= I_DN;
        if (r < I_PL) { p0_transpose_item(a.in[I_WPLE], PLE, DMODEL, DMODEL / 32, (bf16*)(ws + WS_WPLE), scr, r, lane); continue; } r -= I_PL;
        p0_transpose_item(a.in[I_WGATE], DMODEL, DMODEL, DMODEL / 32, (bf16*)(ws + WS_WGATE), scr, r, lane);
    }
    for (int m = gw; m < MROWS; m += NGW) rms_row_to_bf16(a.in[I_XP] + (size_t)m * DMODEL, a.in[I_GMIX], (bf16*)(ws + WS_XN) + (size_t)m * DMODEL, lane);
    { const int gt = vcu * NTHREADS + tid, NGT = G * NTHREADS; const GAS f32x4* src = (const GAS f32x4*)a.in[I_PP]; GAS v4u* dst = (GAS v4u*)(ws + WS_PB);
      for (int i = gt; i < MROWS * PLE / 8; i += NGT) { const f32x4 p0 = src[2 * i], p1 = src[2 * i + 1]; v4u o; o.x = pk2f(p0.x, p0.y); o.y = pk2f(p0.z, p0.w); o.z = pk2f(p1.x, p1.y); o.w = pk2f(p1.z, p1.w); dst[i] = o; } }
}

template <int K> constexpr int sk_pitch() { return 2 * K + 64; }
template <int K> constexpr int sk_red_off() { return 8 * sk_pitch<K>(); }
template <int K, class Op>
__device__ __forceinline__ void skinny_gemm(LAS unsigned char* lds, const bf16* Bt, int ngroups, int first, int stride, int tid, int lane, int wave, const Op& op) {
    constexpr int KS = K / 8, PITCH = sk_pitch<K>();
    LAS float* red = (LAS float*)(lds + sk_red_off<K>());
    const int quad = lane >> 4, c16 = lane & 15;
    for (int cg = first; cg < ngroups; cg += stride) {
        pg8::f32x4 acc = {0.f, 0.f, 0.f, 0.f};
        const bf16* bp = Bt + (size_t)(cg * 16 + c16) * K + wave * KS + 8 * quad;
        const LAS unsigned char* ap = lds + (c16 & 7) * PITCH + (wave * KS + 8 * quad) * 2;
#pragma unroll 8
        for (int k = 0; k < KS; k += 32) {
            const bf16x8 b = *(const GAS bf16x8*)(bp + k);
            bf16x8 av = *(const LAS bf16x8*)(ap + 2 * k);
            if (c16 >= 8) av = (bf16x8){0, 0, 0, 0, 0, 0, 0, 0};
            acc = __builtin_amdgcn_mfma_f32_16x16x32_bf16(av, b, acc, 0, 0, 0);
        }
        if (quad < 2) {
#pragma unroll
            for (int j = 0; j < 4; ++j) red[(wave * 8 + 4 * quad + j) * 16 + c16] = acc[j];
        }
        __syncthreads();
        if (tid < 128) { const int r = tid >> 4, c = tid & 15; float s = 0.f;
#pragma unroll
            for (int w = 0; w < 8; ++w) s += red[(w * 8 + r) * 16 + c];
            op(r, cg * 16 + c, s); }
        __syncthreads();
    }
}
template <int K> __device__ __forceinline__ void sk_fill_rms(LAS unsigned char* lds, const float* src  , const float* g, int lane, int wave) {
    static_assert(K == 2048, "rms rows are d_model wide");
    const GAS f32x4* xr = (const GAS f32x4*)(src + (size_t)wave * K) + lane; const GAS f32x4* gr = (const GAS f32x4*)g + lane;
    f32x4 v[8]; float s = 0.f;
#pragma unroll
    for (int j = 0; j < 8; ++j) { v[j] = xr[64 * j]; s += (v[j].x * v[j].x + v[j].y * v[j].y) + (v[j].z * v[j].z + v[j].w * v[j].w); }
    const float rstd = rsqrtf(wave_sum(s) * (1.f / K) + NORM_EPS);
    LAS unsigned long long* o8 = (LAS unsigned long long*)(lds + wave * sk_pitch<K>()) + lane;
#pragma unroll
    for (int j = 0; j < 8; ++j) { const f32x4 gv = gr[64 * j]; o8[64 * j] = (unsigned long long)pk2f(v[j].x * rstd * gv.x, v[j].y * rstd * gv.y) | ((unsigned long long)pk2f(v[j].z * rstd * gv.z, v[j].w * rstd * gv.w) << 32); }
}
template <int K> __device__ __forceinline__ void sk_fill_f32(LAS unsigned char* lds, const float* src  , int tid) {
    for (int i = tid; i < 8 * K / 4; i += NTHREADS) { const int r = i / (K / 4), c4 = i % (K / 4); const f32x4 v = ((const GAS f32x4*)src)[i];
        *(LAS unsigned long long*)(lds + r * sk_pitch<K>() + c4 * 8) = (unsigned long long)pk2f(v.x, v.y) | ((unsigned long long)pk2f(v.z, v.w) << 32); }
}
template <int K> __device__ __forceinline__ void sk_fill_bf16(LAS unsigned char* lds, const bf16* src  , int tid) {
    for (int i = tid; i < 8 * K / 8; i += NTHREADS) { const int r = i / (K / 8), c8 = i % (K / 8); *(LAS v4u*)(lds + r * sk_pitch<K>() + c8 * 16) = ((const GAS v4u*)src)[i]; }
}

constexpr size_t SM_Y = 704 * 1024;
__device__ __forceinline__ float silu_f(float v) { return v / (1.f + __expf(-v)); }
__device__ __forceinline__ float softplus_f(float x) { return x > 20.f ? x : log1pf(expf(x)); }
__device__ __forceinline__ float sample_conv_act(const Args& a, const float* sproj, int b, int ch) {
    const float* sc = a.in[I_SCONV] + (size_t)b * 3 * XBC + ch; const float* cw = a.in[I_CONVW] + ch;
    const float v = a.in[I_CONVB][ch] + sc[0] * cw[0] + sc[XBC] * cw[XBC] + sc[2 * XBC] * cw[2 * XBC] + sproj[b * SPROJ_LD + C_X + ch] * cw[3 * XBC];
    return silu_f(v);
}
__device__ __forceinline__ void phase2_conv(const Args& a, LAS unsigned char* lds, int tid, int lane, int wave, int bx, int G) {
    unsigned char* ws = a.ws;
    const bf16* proj = (const bf16*)(ws + WS_PROJ); bf16* xa = (bf16*)(ws + WS_XA);
    for (int u = bx; u < MROWS / 32; u += G) {
        if (tid < 384) {
            const int cgp = tid % 192, rh = tid / 192, r0 = u * 32 + rh * 16, ch0 = cgp * 8;
            float w[4][8], bias[8];
#pragma unroll
            for (int j = 0; j < 4; ++j) { const f32x4 w0 = *(const GAS f32x4*)(a.in[I_CONVW] + j * XBC + ch0), w1 = *(const GAS f32x4*)(a.in[I_CONVW] + j * XBC + ch0 + 4);
                w[j][0] = w0.x; w[j][1] = w0.y; w[j][2] = w0.z; w[j][3] = w0.w; w[j][4] = w1.x; w[j][5] = w1.y; w[j][6] = w1.z; w[j][7] = w1.w; }
            { const f32x4 b0 = *(const GAS f32x4*)(a.in[I_CONVB] + ch0), b1 = *(const GAS f32x4*)(a.in[I_CONVB] + ch0 + 4);
              bias[0] = b0.x; bias[1] = b0.y; bias[2] = b0.z; bias[3] = b0.w; bias[4] = b1.x; bias[5] = b1.y; bias[6] = b1.z; bias[7] = b1.w; }
            v4u raw[19];
#pragma unroll
            for (int i = 0; i < 19; ++i) { const int row = r0 - 3 + i; const bool ok = (i >= 3) || ((r0 & (SEQ - 1)) != 0);
                raw[i] = ok ? *(const GAS v4u*)(proj + (size_t)row * NPAD + C_X + ch0) : (v4u){0u, 0u, 0u, 0u}; }
            float x0[8], x1[8], x2[8];
#define CV8(dst, r) do { dst[0] = bflo(r.x); dst[1] = bfhi(r.x); dst[2] = bflo(r.y); dst[3] = bfhi(r.y); dst[4] = bflo(r.z); dst[5] = bfhi(r.z); dst[6] = bflo(r.w); dst[7] = bfhi(r.w); } while (0)
            CV8(x0, raw[0]); CV8(x1, raw[1]); CV8(x2, raw[2]);
#pragma unroll
            for (int i = 3; i < 19; ++i) { float x3[8], o[8]; CV8(x3, raw[i]);
#pragma unroll
                for (int e = 0; e < 8; ++e) { o[e] = silu_f(bias[e] + x0[e] * w[0][e] + x1[e] * w[1][e] + x2[e] * w[2][e] + x3[e] * w[3][e]); x0[e] = x1[e]; x1[e] = x2[e]; x2[e] = x3[e]; }
                v4u ov; ov.x = pk2f(o[0], o[1]); ov.y = pk2f(o[2], o[3]); ov.z = pk2f(o[4], o[5]); ov.w = pk2f(o[6], o[7]);
                *(GAS v4u*)(xa + (size_t)(r0 + i - 3) * XBC + ch0) = ov; }
#undef CV8
        }
    }
    for (int u = bx; u < MROWS / 128; u += G) {
        LAS float* tot = (LAS float*)lds;
        float da[16];
        const int r = tid - 384, row = u * 128 + r;
        if (tid >= 384) {
            const float* dtr = (const float*)(ws + WS_DT) + (size_t)row * 16; float* dtv = (float*)(ws + WS_DTV) + (size_t)row * 16;
#pragma unroll
            for (int h = 0; h < 16; ++h) { const float d = softplus_f(dtr[h] + a.in[I_DTB][h]); dtv[h] = d; da[h] = -d * expf(a.in[I_ALOG][h]); }
#pragma unroll
            for (int h = 0; h < 16; ++h) {
#pragma unroll
                for (int o = 1; o < 64; o <<= 1) { const float t = __shfl_up(da[h], o); if (lane >= o) da[h] += t; } }
            if (wave == 6 && lane == 63) {
#pragma unroll
                for (int h = 0; h < 16; ++h) tot[h] = da[h]; }
        }
        __syncthreads();
        if (tid >= 384) { float* acs = (float*)(ws + WS_ACS) + (size_t)row * 16;
#pragma unroll
            for (int h = 0; h < 16; ++h) acs[h] = da[h] + (wave == 7 ? tot[h] : 0.f); }
        __syncthreads();
    }
    {
        const float* sproj = (const float*)(ws + WS_SMP + SM_PROJ); float* ysm = (float*)(ws + WS_SMP + SM_Y);
        const int gw = bx * NWAVES + wave, NGW = G * NWAVES;
        for (int rr = gw; rr < DB * 16 * 64; rr += NGW) {
            const int b = rr >> 10, h = (rr >> 6) & 15, p = rr & 63, g = h >> 3;
            const float dtv = softplus_f(sproj[b * SPROJ_LD + C_DT + h] + a.in[I_DTB][h]);
            const float dA = expf(-dtv * expf(a.in[I_ALOG][h]));
            const float xd = sample_conv_act(a, sproj, b, h * 64 + p) * dtv;
            const int n0 = 2 * lane;
            const float B0 = sample_conv_act(a, sproj, b, 1024 + g * 128 + n0), B1 = sample_conv_act(a, sproj, b, 1024 + g * 128 + n0 + 1);
            const float C0 = sample_conv_act(a, sproj, b, 1280 + g * 128 + n0), C1 = sample_conv_act(a, sproj, b, 1280 + g * 128 + n0 + 1);
            const size_t so = (size_t)rr * 128 + n0;
            const float s0 = a.in[I_SSM][so] * dA + xd * B0, s1 = a.in[I_SSM][so + 1] * dA + xd * B1;
            a.out[O_SS + so] = s0; a.out[O_SS + so + 1] = s1;
            const float y = wave_sum(s0 * C0 + s1 * C1);
            if (lane == 0) ysm[b * 1024 + h * 64 + p] = y;
        }
        const int gt = bx * NTHREADS + tid, NGT = G * NTHREADS;
        for (int i = gt; i < DB * 3 * XBC; i += NGT) { const int b = i / (3 * XBC), j = (i / XBC) % 3, ch = i % XBC;
            a.out[O_CS + i] = (j < 2) ? a.in[I_SCONV][(size_t)b * 3 * XBC + (j + 1) * XBC + ch] : sproj[b * SPROJ_LD + C_X + ch]; }
    }
}

typedef float f32x16 __attribute__((ext_vector_type(16)));
#define MFMA32(a, b, c) __builtin_amdgcn_mfma_f32_32x32x16_bf16((a), (b), (c), 0, 0, 0)
constexpr int AT_KPITCH = 1040, AT_KMAP = 8 * AT_KPITCH, AT_VD0 = 4160, AT_V = 2 * AT_KMAP, AT_STAGE = AT_V + 4 * AT_VD0;
constexpr int AT_WSF = 2 * AT_STAGE;
__device__ __forceinline__ int crow16(int i, int hi) { return (i & 3) + 8 * (i >> 2) + 4 * hi; }
__device__ __forceinline__ float diff_lambda(const Args& a, int lane) {
    const float s1 = wave_sum(a.in[I_LQ1][lane] * a.in[I_LK1][lane]), s2 = wave_sum(a.in[I_LQ2][lane] * a.in[I_LK2][lane]);
    return expf(s1) - expf(s2) + LAM_INIT;
}
__device__ __forceinline__ void attn_unit(const Args& a, LAS unsigned char* lds, int b, int h, int qb, float lam, int tid, int lane, int wave) {
    unsigned char* ws = a.ws; const bf16* proj = (const bf16*)(ws + WS_PROJ);
    const int c = wave >> 2, wq = wave & 3, r32 = lane & 31, hi = lane >> 5;
    const int q0 = qb * 128, qw0 = q0 + 32 * wq; const size_t rowb = (size_t)b * SEQ;
    const float sl2 = exp2f(-(float)(h + 1)) * LOG2E;
    bf16x8 qr[4];
    { const bf16* qp = proj + (rowb + qw0 + r32) * NPAD + C_Q + h * 128 + c * 64 + hi * 8;
#pragma unroll
      for (int d0 = 0; d0 < 4; ++d0) qr[d0] = *(const GAS bf16x8*)(qp + d0 * 16); }
    const bf16* kg = proj + rowb * NPAD + C_K + h * 128; const bf16* vg = proj + rowb * NPAD + C_V + h * 128;
    int koff[2], voff[2]; unsigned goff[2];
#pragma unroll
    for (int k = 0; k < 2; ++k) { const int i = tid + NTHREADS * k, key = i >> 4, ch = i & 15;
        goff[k] = (unsigned)(key * NPAD + ch * 8) * 2u;
        koff[k] = (ch >> 3) * AT_KMAP + (ch & 7) * AT_KPITCH + key * 16;
        voff[k] = AT_V + (ch >> 2) * AT_VD0 + (key >> 4) * 1024 + (key & 15) * 64 + (ch & 3) * 16; }
    const int nT = 2 * qb + 2;
    v4u kreg[2], vreg[2];
#define AT_LOAD(t) do { const unsigned char* kt = (const unsigned char*)(kg + (size_t)(t) * 64 * NPAD); const unsigned char* vt = (const unsigned char*)(vg + (size_t)(t) * 64 * NPAD); _Pragma("unroll") for (int k = 0; k < 2; ++k) { kreg[k] = *(const GAS v4u*)(kt + goff[k]); vreg[k] = *(const GAS v4u*)(vt + goff[k]); } } while (0)
#define AT_STORE(st) do { _Pragma("unroll") for (int k = 0; k < 2; ++k) { *(LAS v4u*)(lds + (st) * AT_STAGE + koff[k]) = kreg[k]; *(LAS v4u*)(lds + (st) * AT_STAGE + voff[k]) = vreg[k]; } } while (0)
    AT_LOAD(nT - 1); AT_STORE(0);
    __syncthreads();
    f32x16 o[4];
#pragma unroll
    for (int d = 0; d < 4; ++d)
#pragma unroll
        for (int i = 0; i < 16; ++i) o[d][i] = 0.f;
    float m = -INFINITY, lsum = 0.f;
    LAS float* wsf = (LAS float*)(lds + AT_WSF) + wave * 64;
    const int vtr = ((lane >> 4) & 1) * 32 + (lane & 3) * 8 + (4 * hi + ((lane & 15) >> 2)) * 64;
    for (int it = 0; it < nT; ++it) {
        const int t = nT - 1 - it, st = it & 1, k0 = 64 * t;
        if (it + 1 < nT) AT_LOAD(t - 1);
        if (k0 <= qw0 + 31) {
            const LAS unsigned char* Kc = lds + st * AT_STAGE + c * AT_KMAP + hi * AT_KPITCH + r32 * 16;
            f32x16 p0, p1;
#pragma unroll
            for (int i = 0; i < 16; ++i) { p0[i] = 0.f; p1[i] = 0.f; }
#pragma unroll
            for (int d0 = 0; d0 < 4; ++d0) {
                const bf16x8 a0 = *(const LAS bf16x8*)(Kc + d0 * 2 * AT_KPITCH), a1 = *(const LAS bf16x8*)(Kc + d0 * 2 * AT_KPITCH + 512);
                p0 = MFMA32(a0, qr[d0], p0); p1 = MFMA32(a1, qr[d0], p1); }
            const int dq = k0 + 4 * hi - (qw0 + r32);
            const float fb = sl2 * (float)dq;
#pragma unroll
            for (int i = 0; i < 16; ++i) { const int kk = (i & 3) + 8 * (i >> 2); p0[i] += fb + sl2 * (float)kk; p1[i] += fb + sl2 * (float)(kk + 32); }
            if (k0 + 63 > qw0) {
#pragma unroll
                for (int i = 0; i < 16; ++i) { const int kk = (i & 3) + 8 * (i >> 2); if (dq + kk > 0) p0[i] = -INFINITY; if (dq + kk + 32 > 0) p1[i] = -INFINITY; }
            }
            float mx = fmaxf(p0[0], p1[0]);
#pragma unroll
            for (int i = 1; i < 16; ++i) mx = fmaxf(mx, fmaxf(p0[i], p1[i]));
            mx = fmaxf(mx, __shfl_xor(mx, 32));
            const float mn = fmaxf(m, mx), alpha = __builtin_amdgcn_exp2f(m - mn); m = mn;
            float rs = 0.f;
#pragma unroll
            for (int i = 0; i < 16; ++i) { p0[i] = __builtin_amdgcn_exp2f(p0[i] - mn); p1[i] = __builtin_amdgcn_exp2f(p1[i] - mn); rs += p0[i] + p1[i]; }
            lsum = lsum * alpha + rs;
            if (__any(alpha != 1.f)) {
                if (hi == 0) wsf[r32] = alpha;
                asm volatile("s_waitcnt lgkmcnt(0)" ::: "memory");
#pragma unroll
                for (int g4 = 0; g4 < 4; ++g4) { const f32x4 al = *(const LAS f32x4*)(wsf + 8 * g4 + 4 * hi);
#pragma unroll
                    for (int d = 0; d < 4; ++d) { o[d][4 * g4 + 0] *= al.x; o[d][4 * g4 + 1] *= al.y; o[d][4 * g4 + 2] *= al.z; o[d][4 * g4 + 3] *= al.w; } }
            }
            bf16x8 pa[4];
            { v4u w;
              w.x = cvtpk_s(p0[0], p0[1]); w.y = cvtpk_s(p0[2], p0[3]); w.z = cvtpk_s(p0[4], p0[5]); w.w = cvtpk_s(p0[6], p0[7]); pa[0] = __builtin_bit_cast(bf16x8, w);
              w.x = cvtpk_s(p0[8], p0[9]); w.y = cvtpk_s(p0[10], p0[11]); w.z = cvtpk_s(p0[12], p0[13]); w.w = cvtpk_s(p0[14], p0[15]); pa[1] = __builtin_bit_cast(bf16x8, w);
              w.x = cvtpk_s(p1[0], p1[1]); w.y = cvtpk_s(p1[2], p1[3]); w.z = cvtpk_s(p1[4], p1[5]); w.w = cvtpk_s(p1[6], p1[7]); pa[2] = __builtin_bit_cast(bf16x8, w);
              w.x = cvtpk_s(p1[8], p1[9]); w.y = cvtpk_s(p1[10], p1[11]); w.z = cvtpk_s(p1[12], p1[13]); w.w = cvtpk_s(p1[14], p1[15]); pa[3] = __builtin_bit_cast(bf16x8, w); }
            const LAS unsigned char* Vb = lds + st * AT_STAGE + AT_V + vtr;
#pragma unroll
            for (int d = 0; d < 4; ++d)
#pragma unroll
                for (int ks = 0; ks < 4; ++ks) {
                    const v4i16_t lo = __builtin_amdgcn_ds_read_tr16_b64_v4i16((LAS v4i16_t*)(Vb + d * AT_VD0 + ks * 1024));
                    const v4i16_t hv = __builtin_amdgcn_ds_read_tr16_b64_v4i16((LAS v4i16_t*)(Vb + d * AT_VD0 + ks * 1024 + 512));
                    const bf16x8 vb = (bf16x8){lo[0], lo[1], lo[2], lo[3], hv[0], hv[1], hv[2], hv[3]};
                    o[d] = MFMA32(pa[ks], vb, o[d]); }
        }
        if (it + 1 < nT) AT_STORE(st ^ 1);
        __syncthreads();
    }
#undef AT_LOAD
#undef AT_STORE
    const float ltot = lsum + __shfl_xor(lsum, 32);
    const float fac = (c == 0 ? 1.f : -lam) / ltot;
    if (hi == 0) wsf[r32] = fac;
    asm volatile("s_waitcnt lgkmcnt(0)" ::: "memory");
#pragma unroll
    for (int g4 = 0; g4 < 4; ++g4) { const f32x4 al = *(const LAS f32x4*)(wsf + 8 * g4 + 4 * hi);
#pragma unroll
        for (int d = 0; d < 4; ++d) { o[d][4 * g4 + 0] *= al.x; o[d][4 * g4 + 1] *= al.y; o[d][4 * g4 + 2] *= al.z; o[d][4 * g4 + 3] *= al.w; } }
    LAS float* xb = (LAS float*)lds + wq * 4096;
    LAS float* xbl = xb + (4 * hi) * 128 + r32;
    if (c == 1) {
#pragma unroll
        for (int d = 0; d < 4; ++d)
#pragma unroll
            for (int i = 0; i < 16; ++i) xbl[((i & 3) + 8 * (i >> 2)) * 128 + 32 * d] = o[d][i];
    }
    __syncthreads();
    if (c == 0) {
        float ssq[16];
#pragma unroll
        for (int i = 0; i < 16; ++i) { ssq[i] = 0.f;
#pragma unroll
            for (int d = 0; d < 4; ++d) { o[d][i] += xbl[((i & 3) + 8 * (i >> 2)) * 128 + 32 * d]; ssq[i] += o[d][i] * o[d][i]; } }
#pragma unroll
        for (int i = 0; i < 16; ++i) {
#pragma unroll
            for (int x = 1; x < 32; x <<= 1) ssq[i] += __shfl_xor(ssq[i], x);
            ssq[i] = rsqrtf(ssq[i] * (1.f / 128.f) + SUBLN_EPS) * (1.f - LAM_INIT); }
        LAS unsigned short* ob = (LAS unsigned short*)xb;
        LAS unsigned short* obl = ob + (4 * hi) * 128 + r32;
#pragma unroll
        for (int d = 0; d < 4; ++d) { const float wsub = a.in[I_WSUB][32 * d + r32];
#pragma unroll
            for (int i = 0; i < 16; ++i) obl[((i & 3) + 8 * (i >> 2)) * 128 + 32 * d] = (unsigned short)(cvtpk_s(o[d][i] * ssq[i] * wsub, 0.f) & 0xffffu); }
        asm volatile("s_waitcnt lgkmcnt(0)" ::: "memory");
        bf16* mixl = (bf16*)(ws + WS_MIX) + (rowb + qw0 + (lane >> 4)) * DMODEL + h * 128 + (lane & 15) * 8;
        const LAS unsigned char* obr = (const LAS unsigned char*)ob + (lane >> 4) * 256 + (lane & 15) * 16;
#pragma unroll
        for (int k = 0; k < 8; ++k) *(GAS v4u*)(mixl + (size_t)k * 4 * DMODEL) = *(const LAS v4u*)(obr + k * 1024);
    }
    __syncthreads();
}

constexpr int TP = 272, TILE_BYTES = 128 * TP;
__device__ __forceinline__ unsigned row_lane_off(unsigned lane) { return (lane & 15) * TP + (lane >> 4) * 16; }
__device__ __forceinline__ unsigned tr_lane_off(unsigned lane) { return (8 * (lane >> 4) + ((lane & 15) >> 2)) * TP + (lane & 3) * 8; }
__device__ __forceinline__ bf16x8 lds_row_frag(const LAS unsigned char* tl  , int rb, int s) { return *(const LAS bf16x8*)(tl + rb * 16 * TP + s * 64); }
__device__ __forceinline__ bf16x8 lds_tr_frag(const LAS unsigned char* tl  , int c, int ks) {
    const v4i16_t lo = __builtin_amdgcn_ds_read_tr16_b64_v4i16((LAS v4i16_t*)(tl + (32 * ks) * TP + c * 32));
    const v4i16_t hi = __builtin_amdgcn_ds_read_tr16_b64_v4i16((LAS v4i16_t*)(tl + (32 * ks + 4) * TP + c * 32));
    return (bf16x8){lo[0], lo[1], lo[2], lo[3], hi[0], hi[1], hi[2], hi[3]};
}
#define MFMA16(a, b, c) __builtin_amdgcn_mfma_f32_16x16x32_bf16((a), (b), (c), 0, 0, 0)

__device__ __forceinline__ void stage_tile_plain(LAS unsigned char* tile, const bf16* src, int ld, int tid) {
#pragma unroll
    for (int k = 0; k < 4; ++k) { const int r = (tid >> 4) + 32 * k, ch = tid & 15; *(LAS v4u*)(tile + (tid >> 4) * TP + ch * 16 + k * 32 * TP) = *(const GAS v4u*)(src + (size_t)r * ld + ch * 8); }
}
__device__ __forceinline__ v4u scale8(v4u r, float w) {
    v4u o; o.x = pk2f(bflo(r.x) * w, bfhi(r.x) * w); o.y = pk2f(bflo(r.y) * w, bfhi(r.y) * w); o.z = pk2f(bflo(r.z) * w, bfhi(r.z) * w); o.w = pk2f(bflo(r.w) * w, bfhi(r.w) * w); return o;
}

__device__ __forceinline__ void ssd_states_unit(const Args& a, LAS unsigned char* lds, int u, int tid, int lane, int wave) {
    unsigned char* ws = a.ws;
    const int b = u >> 7, c = (u >> 2) & 31, g = (u >> 1) & 1, half = u & 1; const int R0 = b * SEQ + c * 128;
    const bf16* xa = (const bf16*)(ws + WS_XA); const float* dtv = (const float*)(ws + WS_DTV); const float* acs = (const float*)(ws + WS_ACS);
    LAS unsigned char* Bt = lds; LAS unsigned char* Xt = lds + TILE_BYTES;
    const LAS unsigned char* Btr = Bt + tr_lane_off(lane); const LAS unsigned char* Xtr = Xt + tr_lane_off(lane);
    stage_tile_plain(Bt, xa + (size_t)R0 * XBC + 1024 + g * 128, XBC, tid);
    for (int hp = 0; hp < 2; ++hp) {
        const int h0 = g * 8 + half * 4 + hp * 2;
        { const int ch = tid & 15, h = h0 + (ch >> 3); const float alast = acs[(size_t)(R0 + 127) * 16 + h];
#pragma unroll
          for (int k = 0; k < 4; ++k) { const int s = (tid + NTHREADS * k) >> 4; const size_t ro = (size_t)(R0 + s);
              const float w = dtv[ro * 16 + h] * __expf(alast - acs[ro * 16 + h]);
              const v4u raw = *(const GAS v4u*)(xa + ro * XBC + h * 64 + (ch & 7) * 8);
              *(LAS v4u*)(Xt + (tid >> 4) * TP + ch * 16 + k * 32 * TP) = scale8(raw, w); } }
        __syncthreads();
        const int hh = wave >> 2, pblk = wave & 3;
        pg8::f32x4 acc[8];
#pragma unroll
        for (int nb = 0; nb < 8; ++nb) acc[nb] = (pg8::f32x4){0.f, 0.f, 0.f, 0.f};
#pragma unroll
        for (int ks = 0; ks < 4; ++ks) { const bf16x8 af = lds_tr_frag(Xtr + (hh * 4 + pblk) * 32, 0, ks);
#pragma unroll
            for (int nb = 0; nb < 8; ++nb) { const bf16x8 bfr = lds_tr_frag(Btr, nb, ks); acc[nb] = MFMA16(af, bfr, acc[nb]); } }
        float* st = (float*)(ws + WS_STATES) + ((size_t)((b * 32 + c) * 16 + h0 + hh)) * 8192;
#pragma unroll
        for (int nb = 0; nb < 8; ++nb)
#pragma unroll
            for (int j = 0; j < 4; ++j) st[(16 * pblk + 4 * (lane >> 4) + j) * 128 + 16 * nb + (lane & 15)] = acc[nb][j];
        __syncthreads();
    }
}

__device__ __forceinline__ void ssd_scan(const Args& a, int tid, int bx, int G) {
    unsigned char* ws = a.ws; typedef float f32x2 __attribute__((ext_vector_type(2)));
    const int NGT = G * NTHREADS;
    for (int i = bx * NTHREADS + tid; i < 2 * 16 * 64 * 64; i += NGT) {
        const int n2 = i & 63, p = (i >> 6) & 63, h = (i >> 12) & 15, b = i >> 16;
        const size_t eo = (size_t)p * 128 + 2 * n2;
        f32x2 st[32]; float dec[32];
#pragma unroll
        for (int c = 0; c < 32; ++c) { st[c] = *(const GAS f32x2*)((const float*)(ws + WS_STATES) + ((size_t)((b * 32 + c) * 16 + h)) * 8192 + eo);
            dec[c] = ((const float*)(ws + WS_ACS))[(size_t)(b * SEQ + c * 128 + 127) * 16 + h]; }
        f32x2 carry = {0.f, 0.f};
#pragma unroll
        for (int c = 0; c < 32; ++c) {
            *(GAS unsigned*)((bf16*)(ws + WS_SIN) + ((size_t)((b * 32 + c) * 16 + h)) * 8192 + eo) = pk2f(carry.x, carry.y);
            const float d = __expf(dec[c]); carry.x = carry.x * d + st[c].x; carry.y = carry.y * d + st[c].y; }
        *(GAS f32x2*)(a.out + O_SP + ((size_t)(b * 16 + h) * 64) * 128 + eo) = carry;
    }
}

__device__ __forceinline__ void ssd_out_unit(const Args& a, LAS unsigned char* lds, int u, int tid, int lane, int wave) {
    unsigned char* ws = a.ws;
    const int b = u >> 6, c = (u >> 1) & 31, g = u & 1; const int R0 = b * SEQ + c * 128;
    const bf16* xa = (const bf16*)(ws + WS_XA); const bf16* proj = (const bf16*)(ws + WS_PROJ); const float* dtv = (const float*)(ws + WS_DTV);
    bf16* mix = (bf16*)(ws + WS_MIX);
    LAS unsigned char* Ct = lds; LAS unsigned char* Bt = lds + TILE_BYTES; LAS unsigned char* Xd = lds + TILE_BYTES; LAS unsigned char* Sn = lds + 2 * TILE_BYTES;
    LAS unsigned char* Gw = lds + 3 * TILE_BYTES + wave * 16 * TP; LAS float* acsl = (LAS float*)(lds + 4 * TILE_BYTES);
    const unsigned rlo = row_lane_off(lane), tlo = tr_lane_off(lane);
    const LAS unsigned char* Cw = Ct + rlo + wave * 16 * TP; const LAS unsigned char* Br = Bt + rlo; const LAS unsigned char* Xtr = Xd + tlo; const LAS unsigned char* Snr = Sn + rlo; const LAS unsigned char* Gr = Gw + rlo;
    stage_tile_plain(Ct, xa + (size_t)R0 * XBC + 1280 + g * 128, XBC, tid);
    stage_tile_plain(Bt, xa + (size_t)R0 * XBC + 1024 + g * 128, XBC, tid);
    for (int i = tid; i < 128 * 8 / 4; i += NTHREADS) ((LAS f32x4*)acsl)[i] = *(const GAS f32x4*)((const float*)(ws + WS_ACS) + (size_t)(R0 + (i >> 1)) * 16 + g * 8 + (i & 1) * 4);
    __syncthreads();
    const int q = lane >> 4, c16 = lane & 15;
    pg8::f32x4 cb[8];
#pragma unroll
    for (int sb = 0; sb < 8; ++sb) cb[sb] = (pg8::f32x4){0.f, 0.f, 0.f, 0.f};
#pragma unroll
    for (int ks = 0; ks < 4; ++ks) { const bf16x8 af = lds_row_frag(Cw, 0, ks);
#pragma unroll
        for (int sb = 0; sb < 8; ++sb) if (sb <= wave) { const bf16x8 bfr = lds_row_frag(Br, sb, ks); cb[sb] = MFMA16(af, bfr, cb[sb]); } }
    __syncthreads();
    float ss[4] = {0.f, 0.f, 0.f, 0.f};
    const int nks = (wave >> 1) + 1;
    for (int hp = 0; hp < 4; ++hp) {
        const int h0 = g * 8 + hp * 2;
        { const int ch = tid & 15, h = h0 + (ch >> 3);
#pragma unroll
          for (int k = 0; k < 4; ++k) { const int s = (tid + NTHREADS * k) >> 4; const size_t ro = (size_t)(R0 + s);
              const v4u raw = *(const GAS v4u*)(xa + ro * XBC + h * 64 + (ch & 7) * 8);
              *(LAS v4u*)(Xd + (tid >> 4) * TP + ch * 16 + k * 32 * TP) = scale8(raw, dtv[ro * 16 + h]); }
          stage_tile_plain(Sn, (const bf16*)(ws + WS_SIN) + ((size_t)((b * 32 + c) * 16 + h0)) * 8192, 128, tid); }
        __syncthreads();
#pragma unroll
        for (int hh = 0; hh < 2; ++hh) {
            const int h = h0 + hh;
            float al[4];
#pragma unroll
            for (int j = 0; j < 4; ++j) al[j] = acsl[(16 * wave + 4 * q + j) * 8 + (h & 7)];
#pragma unroll
            for (int sb = 0; sb < 8; ++sb) if (sb < 2 * nks) { const int s = 16 * sb + c16; const float as = acsl[s * 8 + (h & 7)];
#pragma unroll
                for (int j = 0; j < 4; ++j) { const int l = 16 * wave + 4 * q + j; const float gv = (sb <= wave && s <= l) ? cb[sb][j] * __expf(al[j] - as) : 0.f;
                    *(LAS unsigned short*)(Gw + (4 * q) * TP + c16 * 2 + j * TP + sb * 32) = (unsigned short)(pk2f(gv, 0.f) & 0xffffu); } }
            asm volatile("s_waitcnt lgkmcnt(0)" ::: "memory");
            pg8::f32x4 yd[4], yo[4];
#pragma unroll
            for (int pb = 0; pb < 4; ++pb) { yd[pb] = (pg8::f32x4){0.f, 0.f, 0.f, 0.f}; yo[pb] = (pg8::f32x4){0.f, 0.f, 0.f, 0.f}; }
#pragma unroll
            for (int ks = 0; ks < 4; ++ks) if (ks < nks) { const bf16x8 af = lds_row_frag(Gr, 0, ks);
#pragma unroll
                for (int pb = 0; pb < 4; ++pb) { const bf16x8 bfr = lds_tr_frag(Xtr + hh * 128, pb, ks); yd[pb] = MFMA16(af, bfr, yd[pb]); } }
#pragma unroll
            for (int ks = 0; ks < 4; ++ks) { const bf16x8 af = lds_row_frag(Cw, 0, ks);
#pragma unroll
                for (int pb = 0; pb < 4; ++pb) { const bf16x8 bfr = lds_row_frag(Snr + hh * 64 * TP, pb, ks); yo[pb] = MFMA16(af, bfr, yo[pb]); } }
            const float dsk = a.in[I_DSKIP][h];
#pragma unroll
            for (int j = 0; j < 4; ++j) { const int l = 16 * wave + 4 * q + j; const size_t ro = (size_t)(R0 + l); const float ea = __expf(al[j]);
#pragma unroll
                for (int pb = 0; pb < 4; ++pb) { const int p = 16 * pb + c16;
                    const float xv = bf2f(xa[ro * XBC + h * 64 + p]), zv = bf2f(proj[ro * NPAD + C_Z + h * 64 + p]);
                    const float y = yd[pb][j] + ea * yo[pb][j] + dsk * xv; const float gv = y * silu_f(zv);
                    ss[j] += gv * gv; mix[ro * DMODEL + 1024 + h * 64 + p] = (bf16)(pk2f(gv, 0.f) & 0xffffu); } }
        }
        __syncthreads();
    }
#pragma unroll
    for (int j = 0; j < 4; ++j) { float s = ss[j]; s += __shfl_xor(s, 1); s += __shfl_xor(s, 2); s += __shfl_xor(s, 4); s += __shfl_xor(s, 8); ss[j] = rsqrtf(s * (1.f / 512.f) + NORM_EPS); }
    asm volatile("s_waitcnt vmcnt(0)" ::: "memory");
    for (int hl = 0; hl < 8; ++hl) { const int h = g * 8 + hl;
#pragma unroll
        for (int j = 0; j < 4; ++j) { const size_t ro = (size_t)(R0 + 16 * wave + 4 * q + j);
#pragma unroll
            for (int pb = 0; pb < 4; ++pb) { const int p = 16 * pb + c16; bf16* mp = mix + ro * DMODEL + 1024 + h * 64 + p;
                const float v = bf2f(*(volatile bf16*)mp) * ss[j] * a.in[I_WSSMN][h * 64 + p]; *mp = (bf16)(pk2f(v, 0.f) & 0xffffu); } } }
}
__device__ __forceinline__ void phase5_ssd_out(const Args& a, LAS unsigned char* lds, int tid, int lane, int wave, int bx, int G) {
    for (int u = bx; u < 128; u += G) { ssd_out_unit(a, lds, u, tid, lane, wave); __syncthreads(); }
}

constexpr size_t PART_ML = 0, PART_O = 1 * MiB;
__device__ __forceinline__ void sattn_partial_unit(const Args& a, LAS unsigned char* lds, int u, int tid, int lane, int wave) {
    unsigned char* ws = a.ws;
    const int b = u >> 7, pg = u & 127;
    const int pid = ((const int*)a.in[I_PT])[b * NPAGES + pg];
    const float* kp = a.in[I_CK] + (size_t)pid * PAGE * 1024; const float* vp = a.in[I_CV] + (size_t)pid * PAGE * 1024;
    const float* sproj = (const float*)(ws + WS_SMP + SM_PROJ);
    LAS float* S = (LAS float*)(lds);
    LAS float* red = (LAS float*)(lds + 16384);
    f32x4 qv[4];
#pragma unroll
    for (int i = 0; i < 4; ++i) { const f32x4 t = *(const GAS f32x4*)(sproj + b * SPROJ_LD + C_Q + 4 * lane + 256 * i); qv[i] = t * QSCALE; }
#pragma unroll 4
    for (int tt = 0; tt < 16; ++tt) { const int tok = wave * 16 + tt; const float* kr = kp + (size_t)tok * 1024 + 4 * lane;
        float part[4];
#pragma unroll
        for (int i = 0; i < 4; ++i) { const f32x4 kv = __builtin_nontemporal_load((const GAS f32x4*)(kr + 256 * i)); part[i] = (kv.x * qv[i].x + kv.y * qv[i].y) + (kv.z * qv[i].z + kv.w * qv[i].w); }
#pragma unroll
        for (int i = 0; i < 4; ++i) { float s = part[i]; s += __shfl_xor(s, 1); s += __shfl_xor(s, 2); s += __shfl_xor(s, 4); s += __shfl_xor(s, 8); part[i] = s; }
        if ((lane & 15) == 0) {
            const float dist = (float)(PAST - (pg * PAGE + tok));
#pragma unroll
            for (int i = 0; i < 4; ++i) { const int head = (lane >> 5) + 2 * i, mp = (lane >> 4) & 1; S[tok * 16 + head * 2 + mp] = part[i] - exp2f(-(float)(head + 1)) * LOG2E * dist; } }
    }
    __syncthreads();
    { const int hc = 2 * wave + (lane >> 5), t0 = lane & 31; float sv[4]; float mx = -INFINITY;
#pragma unroll
      for (int k = 0; k < 4; ++k) { sv[k] = S[(t0 + 32 * k) * 16 + hc]; mx = fmaxf(mx, sv[k]); }
#pragma unroll
      for (int x = 1; x < 32; x <<= 1) mx = fmaxf(mx, __shfl_xor(mx, x));
      float ls = 0.f;
#pragma unroll
      for (int k = 0; k < 4; ++k) { sv[k] = exp2f(sv[k] - mx); ls += sv[k]; S[(t0 + 32 * k) * 16 + hc] = sv[k]; }
#pragma unroll
      for (int x = 1; x < 32; x <<= 1) ls += __shfl_xor(ls, x);
      if (t0 == 0) { float* ml = (float*)(ws + WS_PART + PART_ML) + ((size_t)u * 16 + hc) * 2; ml[0] = mx; ml[1] = ls; } }
    __syncthreads();
    f32x4 acc[4][2];
#pragma unroll
    for (int i = 0; i < 4; ++i) { acc[i][0] = (f32x4){0.f, 0.f, 0.f, 0.f}; acc[i][1] = (f32x4){0.f, 0.f, 0.f, 0.f}; }
#pragma unroll 4
    for (int tt = 0; tt < 16; ++tt) { const int tok = wave * 16 + tt; const float* vr = vp + (size_t)tok * 1024 + 4 * lane;
#pragma unroll
        for (int i = 0; i < 4; ++i) { const f32x4 vv = __builtin_nontemporal_load((const GAS f32x4*)(vr + 256 * i)); const int head = (lane >> 5) + 2 * i;
            const float p0 = S[tok * 16 + head * 2], p1 = S[tok * 16 + head * 2 + 1];
            acc[i][0] += vv * p0; acc[i][1] += vv * p1; } }
#pragma unroll
    for (int i = 0; i < 4; ++i) { const int head = (lane >> 5) + 2 * i;
#pragma unroll
        for (int mp = 0; mp < 2; ++mp) *(LAS f32x4*)(red + ((wave * 16 + head * 2 + mp) * 128 + 4 * (lane & 31))) = acc[i][mp]; }
    __syncthreads();
    { float* po = (float*)(ws + WS_PART + PART_O) + (size_t)u * 2048;
      const int e = tid * 4; f32x4 s = {0.f, 0.f, 0.f, 0.f};
#pragma unroll
      for (int w = 0; w < 8; ++w) s += *(const LAS f32x4*)(red + w * 2048 + e);
      *(GAS f32x4*)(po + e) = s; }
    __syncthreads();
}
__device__ __forceinline__ void sattn_combine_wave(const Args& a, int bh, float lam, int lane) {
    unsigned char* ws = a.ws; const int b = bh >> 3, h = bh & 7;
    const float* sproj = (const float*)(ws + WS_SMP + SM_PROJ) + b * SPROJ_LD;
    const float* ml = (const float*)(ws + WS_PART + PART_ML); const float* po = (const float*)(ws + WS_PART + PART_O);
    float on[2][2];
#pragma unroll
    for (int mp = 0; mp < 2; ++mp) {
        const float snew = wave_sum(sproj[C_Q + h * 128 + mp * 64 + lane] * QSCALE * sproj[C_K + h * 128 + mp * 64 + lane]);
        const int hc = h * 2 + mp;
        const float m0 = ml[((size_t)(b * 128 + lane) * 16 + hc) * 2], m1 = ml[((size_t)(b * 128 + lane + 64) * 16 + hc) * 2];
        const float l0 = ml[((size_t)(b * 128 + lane) * 16 + hc) * 2 + 1], l1 = ml[((size_t)(b * 128 + lane + 64) * 16 + hc) * 2 + 1];
        float mg = fmaxf(fmaxf(m0, m1), snew);
#pragma unroll
        for (int x = 1; x < 64; x <<= 1) mg = fmaxf(mg, __shfl_xor(mg, x));
        const float w0 = exp2f(m0 - mg), w1 = exp2f(m1 - mg), wn = exp2f(snew - mg);
        const float L = wave_sum(l0 * w0 + l1 * w1) + wn;
        float o0 = wn * sproj[C_V + h * 128 + 2 * lane], o1 = wn * sproj[C_V + h * 128 + 2 * lane + 1];
        for (int j = 0; j < 64; ++j) { const float wa = __shfl(w0, j), wb = __shfl(w1, j);
            const f32x2_t pa = *(const GAS f32x2_t*)(po + ((size_t)(b * 128 + j) * 16 + hc) * 128 + 2 * lane), pb = *(const GAS f32x2_t*)(po + ((size_t)(b * 128 + j + 64) * 16 + hc) * 128 + 2 * lane);
            o0 += wa * pa.x + wb * pb.x; o1 += wa * pa.y + wb * pb.y; }
        on[mp][0] = o0 / L; on[mp][1] = o1 / L;
    }
    const float d0 = on[0][0] - lam * on[1][0], d1 = on[0][1] - lam * on[1][1];
    const float rn = rsqrtf(wave_sum(d0 * d0 + d1 * d1) * (1.f / 128.f) + SUBLN_EPS) * (1.f - LAM_INIT);
    unsigned* mixs = (unsigned*)((bf16*)(ws + WS_SMP + SM_MIX) + b * DMODEL + h * 128 + 2 * lane);
    *mixs = cvtpk_s(d0 * rn * a.in[I_WSUB][2 * lane], d1 * rn * a.in[I_WSUB][2 * lane + 1]);
}
__device__ __forceinline__ void sssm_out_wave(const Args& a, int bg, int lane) {
    unsigned char* ws = a.ws; const int b = bg >> 1, g = bg & 1;
    const float* sproj = (const float*)(ws + WS_SMP + SM_PROJ); const float* ysm = (const float*)(ws + WS_SMP + SM_Y);
    float gv[8]; float ss = 0.f;
#pragma unroll
    for (int e = 0; e < 8; ++e) { const int ch = g * 512 + lane * 8 + e; const float xs = sample_conv_act(a, sproj, b, ch);
        const float y = ysm[b * 1024 + ch] + a.in[I_DSKIP][ch >> 6] * xs; gv[e] = y * silu_f(sproj[b * SPROJ_LD + C_Z + ch]); ss += gv[e] * gv[e]; }
    const float rn = rsqrtf(wave_sum(ss) * (1.f / 512.f) + NORM_EPS);
    v4u o; float w[8];
#pragma unroll
    for (int e = 0; e < 8; ++e) w[e] = gv[e] * rn * a.in[I_WSSMN][g * 512 + lane * 8 + e];
    o.x = cvtpk_s(w[0], w[1]); o.y = cvtpk_s(w[2], w[3]); o.z = cvtpk_s(w[4], w[5]); o.w = cvtpk_s(w[6], w[7]);
    *(GAS v4u*)((bf16*)(ws + WS_SMP + SM_MIX) + b * DMODEL + 1024 + g * 512 + lane * 8) = o;
}

#ifndef TPROBE
#define TPROBE -1
#endif
__device__ __forceinline__ void phase3_attn_states(const Args& a, LAS unsigned char* lds, int tid, int lane, int wave, int bx, int G, unsigned long long& tp0, unsigned long long& tp1) {
    const float lam = diff_lambda(a, lane);
    const bool stream_first = ((bx >> 3) & 1) != 0;
    if (stream_first) for (int u = bx; u < DB * NPAGES; u += G) sattn_partial_unit(a, lds, u, tid, lane, wave);
    asm volatile("" : "+v"(tid), "+v"(lane));
    for (int j = bx; j < 256; j += G) { const int bh = j >> 4, k = j & 15;
        attn_unit(a, lds, bh >> 3, bh & 7, 31 - k, lam, tid, lane, wave);
        attn_unit(a, lds, bh >> 3, bh & 7, k, lam, tid, lane, wave); }
    asm volatile("" : "+v"(tid), "+v"(lane));
    for (int u = bx; u < 256; u += G) { ssd_states_unit(a, lds, u, tid, lane, wave); }
    asm volatile("" : "+v"(tid), "+v"(lane));
    if (!stream_first) for (int u = bx; u < DB * NPAGES; u += G) sattn_partial_unit(a, lds, u, tid, lane, wave);
}
__device__ __forceinline__ void phase4_scan(const Args& a, LAS unsigned char* lds, int tid, int lane, int wave, int bx, int G) {
    ssd_scan(a, tid, bx, G);
    const int gw = bx * NWAVES + wave, NGW = G * NWAVES;
    const float lam = diff_lambda(a, lane);
    for (int i = gw; i < 64 + 16; i += NGW) { if (i < 64) sattn_combine_wave(a, i, lam, lane); else sssm_out_wave(a, i - 64, lane); }
}

constexpr int N_PHASES = 11;
__global__ void __launch_bounds__(NTHREADS, 2) hymba_fwd(Args args) {
    extern __shared__ __attribute__((aligned(16))) unsigned char lds_raw[];
    LAS unsigned char* lds = (LAS unsigned char*)lds_raw;
    const int tid = threadIdx.x, lane = tid & 63, wave = __builtin_amdgcn_readfirstlane(tid >> 6);
    const int G = gridDim.x; const int bx = blockIdx.x; const int vcu = (G % 8 == 0) ? (bx % 8) * (G / 8) + bx / 8 : bx;
    unsigned char* ws = args.ws; gu32* ctl = (gu32*)(ws + WS_CTL);
    volatile LAS unsigned* MISC = (volatile LAS unsigned*)(lds + MISC_OFF);
    if (tid < 16) MISC[tid] = 0u;
    __syncthreads();
#if MK_SPLIT
#define GRID_BAR() do { } while (0)
#else
    XcdBarrier bar = xcd_barrier_post((unsigned*)(ctl + CW_BAR), MISC + 8);
#define GRID_BAR() xcd_barrier(bar)
#endif
    const int lo = args.ph_lo, hi = args.ph_hi;
#ifndef PHMASK
#define PHMASK 0xffff
#endif
#define IN(k) (((PHMASK >> (k)) & 1) && lo <= (k) && (k) < hi)
#define BOTH(k) (IN(k) && IN((k) + 1))
#ifndef DUPMASK
#define DUPMASK 0
#endif
#define DUPON(k) ((DUPMASK >> (k)) & 1)
    float* out = args.out;
    float* ss1 = (float*)(ctl + CW_SS1); float* sse = (float*)(ctl + CW_SSE); float* ss3 = (float*)(ctl + CW_SS3);
    unsigned char* smp = ws + WS_SMP;

#ifndef TPROBE
#define TPROBE -1
#endif
#define TP_AMP 4
    unsigned long long tp0 = 0, tp1 = 0;
#define TP_BEGIN(k) do { if (TPROBE == (k)) tp0 = __builtin_amdgcn_s_memrealtime(); } while (0)
#define TP_END(k) do { if (TPROBE == (k)) tp1 = __builtin_amdgcn_s_memrealtime(); } while (0)
    TP_BEGIN(0);
    if (IN(0)) { phase0_prologue(args, lds, tid, lane, wave, vcu, G); if (DUPON(0)) { __syncthreads(); phase0_prologue(args, lds, tid, lane, wave, vcu, G); } if (BOTH(0)) GRID_BAR(); }

    TP_END(0);
    TP_BEGIN(1);
    if (IN(1)) {
        { pg8::Gemm g{(const pg8::bf16_t*)(ws + WS_XN), (const pg8::bf16_t*)(ws + WS_WIN), MROWS, NPAD, DMODEL}; pg8::StaticOrder S; S.init(MROWS, NPAD, G, bx);
          pg8::EpiProj E{(pg8::bf16_t*)(ws + WS_PROJ), out + O_KP, out + O_VP, out + O_CP, (float*)(ws + WS_DT)};
          pg8::gemm_phase<pg8::EpiProj, pg8::StaticOrder, true, true>(lds, g, S, E);
          if (DUPON(1)) { __syncthreads(); pg8::gemm_phase<pg8::EpiProj, pg8::StaticOrder, true, true>(lds, g, S, E); } }
        __syncthreads();
        { sk_fill_rms<DMODEL>(lds, args.in[I_XS], args.in[I_GMIX], lane, wave); __syncthreads();
          float* sp = (float*)(smp + SM_PROJ); float* ks = out + O_KS; float* vs = out + O_VS;
          auto op = [=](int r, int col, float v) { sp[r * SPROJ_LD + col] = v; if (col >= C_K && col < C_V) ks[r * 1024 + col - C_K] = v; else if (col >= C_V && col < C_Z) vs[r * 1024 + col - C_V] = v; };
          skinny_gemm<DMODEL>(lds, (const bf16*)(ws + WS_WIN), NPROJ / 16, bx, G, tid, lane, wave, op); }
        if (BOTH(1)) GRID_BAR();
    }
    TP_END(1);
    TP_BEGIN(2);
    if (IN(2)) { phase2_conv(args, lds, tid, lane, wave, bx, G); if (DUPON(2)) { __syncthreads(); phase2_conv(args, lds, tid, lane, wave, bx, G); } if (BOTH(2)) GRID_BAR(); }
    TP_END(2);
    TP_BEGIN(3);
    if (IN(3)) { phase3_attn_states(args, lds, tid, lane, wave, bx, G, tp0, tp1); if (BOTH(3)) GRID_BAR(); }
    TP_END(3);
    TP_BEGIN(4);
    if (IN(4)) { phase4_scan(args, lds, tid, lane, wave, bx, G); if (DUPON(4)) { __syncthreads(); phase4_scan(args, lds, tid, lane, wave, bx, G); } if (BOTH(4)) GRID_BAR(); }
    TP_END(4);
    TP_BEGIN(5);
    if (IN(5)) {
        TP_BEGIN(51); phase5_ssd_out(args, lds, tid, lane, wave, bx, G);
        __syncthreads(); TP_END(51);
        if (DUPON(5)) { phase5_ssd_out(args, lds, tid, lane, wave, bx, G); __syncthreads(); }
        { pg8::Gemm g{(const pg8::bf16_t*)(ws + WS_PB), (const pg8::bf16_t*)(ws + WS_WPLE), MROWS, DMODEL, PLE}; pg8::StaticOrder S; S.init(MROWS, DMODEL, G, bx);
          pg8::EpiPle E{(float*)(ws + WS_E0), sse};
          pg8::gemm_phase<pg8::EpiPle, pg8::StaticOrder, true, true>(lds, g, S, E); }
        __syncthreads();
        { sk_fill_bf16<DMODEL>(lds, (const bf16*)(smp + SM_MIX), tid); __syncthreads();
          float* h1s = (float*)(smp + SM_H1); const float* xs = args.in[I_XS];
          auto op = [=](int r, int col, float v) { h1s[r * DMODEL + col] = xs[r * DMODEL + col] + v; };
          skinny_gemm<DMODEL>(lds, (const bf16*)(ws + WS_WOUT), DMODEL / 16, bx, G, tid, lane, wave, op); }
        if (BOTH(5)) GRID_BAR();
    }
    TP_END(5);
    TP_BEGIN(6);
    if (IN(6)) {
        { pg8::Gemm g{(const pg8::bf16_t*)(ws + WS_MIX), (const pg8::bf16_t*)(ws + WS_WOUT), MROWS, DMODEL, DMODEL}; pg8::StaticOrder S; S.init(MROWS, DMODEL, G, bx);
          pg8::EpiOut E{args.in[I_XP], (float*)(ws + WS_H1), (pg8::bf16_t*)(ws + WS_XN), args.in[I_GFFN], ss1};
          pg8::gemm_phase<pg8::EpiOut, pg8::StaticOrder, true, true>(lds, g, S, E); }
        __syncthreads();
        { sk_fill_rms<DMODEL>(lds, (const float*)(smp + SM_H1), args.in[I_GFFN], lane, wave); __syncthreads();
          bf16* hid = (bf16*)(smp + SM_HID);
          auto op = [=](int r, int col, float v) { const float t = fmaxf(v, 0.f); hid[r * DFF + col] = (bf16)(pk2f(t * t, 0.f) & 0xffffu); };
          skinny_gemm<DMODEL>(lds, (const bf16*)(ws + WS_WUP), DFF / 16, bx, G, tid, lane, wave, op); }
        if (BOTH(6)) GRID_BAR();
    }
    TP_END(6);
    TP_BEGIN(7);
    if (IN(7)) {
        { pg8::Gemm g{(const pg8::bf16_t*)(ws + WS_XN), (const pg8::bf16_t*)(ws + WS_WUP), MROWS, DFF, DMODEL}; pg8::StaticOrder S; S.init(MROWS, DFF, G, bx);
          pg8::EpiUp E{(pg8::bf16_t*)(ws + WS_HB), ss1};
          pg8::gemm_phase<pg8::EpiUp, pg8::StaticOrder, true, true>(lds, g, S, E);
          if (DUPON(7)) { __syncthreads(); pg8::gemm_phase<pg8::EpiUp, pg8::StaticOrder, true, true>(lds, g, S, E); } }
        __syncthreads();
        { sk_fill_bf16<DFF>(lds, (const bf16*)(smp + SM_HID), tid); __syncthreads();
          float* h2s = (float*)(smp + SM_H2); const float* h1s = (const float*)(smp + SM_H1);
          auto op = [=](int r, int col, float v) { h2s[r * DMODEL + col] = h1s[r * DMODEL + col] + v; };
          skinny_gemm<DFF>(lds, (const bf16*)(ws + WS_WDOWN), DMODEL / 16, bx, G, tid, lane, wave, op); }
        if (BOTH(7)) GRID_BAR();
    }
    TP_END(7);
    TP_BEGIN(8);
    if (IN(8)) {
        { pg8::Gemm g{(const pg8::bf16_t*)(ws + WS_HB), (const pg8::bf16_t*)(ws + WS_WDOWN), MROWS, DMODEL, DFF}; pg8::StaticOrder S; S.init(MROWS, DMODEL, G, bx);
          pg8::EpiDown E{(float*)(ws + WS_H1), (pg8::bf16_t*)(ws + WS_XN)};
          pg8::gemm_phase<pg8::EpiDown, pg8::StaticOrder, true, true>(lds, g, S, E); }
        __syncthreads();
        { sk_fill_f32<PLE>(lds, args.in[I_PS], tid); __syncthreads();
          float* e0s = (float*)(smp + SM_E0);
          auto op = [=](int r, int col, float v) { e0s[r * DMODEL + col] = v; };
          skinny_gemm<PLE>(lds, (const bf16*)(ws + WS_WPLE), DMODEL / 16, bx, G, tid, lane, wave, op); }
        __syncthreads();
        { sk_fill_f32<DMODEL>(lds, (const float*)(smp + SM_H2), tid); __syncthreads();
          float* gs = (float*)(smp + SM_GATE);
          auto op = [=](int r, int col, float v) { gs[r * DMODEL + col] = v; };
          skinny_gemm<DMODEL>(lds, (const bf16*)(ws + WS_WGATE), DMODEL / 16, bx, G, tid, lane, wave, op); }
        if (BOTH(8)) GRID_BAR();
    }
    TP_END(8);
    TP_BEGIN(9);
    if (IN(9)) {
        { pg8::Gemm g{(const pg8::bf16_t*)(ws + WS_XN), (const pg8::bf16_t*)(ws + WS_WGATE), MROWS, DMODEL, DMODEL}; pg8::StaticOrder S; S.init(MROWS, DMODEL, G, bx);
          pg8::EpiGate E{(const float*)(ws + WS_H1), (const float*)(ws + WS_E0), sse, args.in[I_WPLEN], out + O_YP, ss3};
          pg8::gemm_phase<pg8::EpiGate, pg8::StaticOrder, true, true>(lds, g, S, E); }
        if (BOTH(9)) GRID_BAR();
    }
    TP_END(9);
    TP_BEGIN(10);
    if (IN(10)) {
        const int gw = vcu * NWAVES + wave, NGW = G * NWAVES;
        const GAS f32x4* gf = (const GAS f32x4*)args.in[I_GFIN] + lane;
        for (int m = gw; m < MROWS; m += NGW) {
            const float rstd = rsqrtf(ss3[m] * (1.f / DMODEL) + NORM_EPS);
            GAS f32x4* yr = (GAS f32x4*)(out + O_YP + (size_t)m * DMODEL) + lane;
#pragma unroll
            for (int j = 0; j < 8; ++j) { f32x4 v = yr[64 * j]; const f32x4 gv = gf[64 * j]; v.x *= rstd * gv.x; v.y *= rstd * gv.y; v.z *= rstd * gv.z; v.w *= rstd * gv.w; yr[64 * j] = v; }
        }
        if (bx == G - 1) {
            const int r = wave;
            const GAS f32x4* h2 = (const GAS f32x4*)(smp + SM_H2 + (size_t)r * DMODEL * 4) + lane; const GAS f32x4* e0 = (const GAS f32x4*)(smp + SM_E0 + (size_t)r * DMODEL * 4) + lane;
            const GAS f32x4* gt = (const GAS f32x4*)(smp + SM_GATE + (size_t)r * DMODEL * 4) + lane; const GAS f32x4* wn = (const GAS f32x4*)args.in[I_WPLEN] + lane;
            f32x4 ev[8]; float se = 0.f;
#pragma unroll
            for (int j = 0; j < 8; ++j) { ev[j] = e0[64 * j]; se += (ev[j].x * ev[j].x + ev[j].y * ev[j].y) + (ev[j].z * ev[j].z + ev[j].w * ev[j].w); }
            const float rstde = rsqrtf(wave_sum(se) * (1.f / DMODEL) + NORM_EPS);
            f32x4 h3[8]; float s3 = 0.f;
#pragma unroll
            for (int j = 0; j < 8; ++j) { const f32x4 hv = h2[64 * j], gv = gt[64 * j], wv = wn[64 * j]; f32x4 o;
                o.x = hv.x + ev[j].x * rstde * wv.x / (1.f + __expf(-gv.x)); o.y = hv.y + ev[j].y * rstde * wv.y / (1.f + __expf(-gv.y));
                o.z = hv.z + ev[j].z * rstde * wv.z / (1.f + __expf(-gv.z)); o.w = hv.w + ev[j].w * rstde * wv.w / (1.f + __expf(-gv.w));
                h3[j] = o; s3 += (o.x * o.x + o.y * o.y) + (o.z * o.z + o.w * o.w); }
            const float rstd = rsqrtf(wave_sum(s3) * (1.f / DMODEL) + NORM_EPS);
            GAS f32x4* yr = (GAS f32x4*)(out + O_YS + (size_t)r * DMODEL) + lane;
#pragma unroll
            for (int j = 0; j < 8; ++j) { const f32x4 gv = gf[64 * j]; f32x4 o = h3[j]; o.x *= rstd * gv.x; o.y *= rstd * gv.y; o.z *= rstd * gv.z; o.w *= rstd * gv.w; yr[64 * j] = o; }
        }
    }
    TP_END(10);
    if (TPROBE >= 0 && bx == 0 && tid == 0) { const unsigned long long t = __builtin_amdgcn_s_memrealtime(), d = (tp1 - tp0) * TP_AMP; while (__builtin_amdgcn_s_memrealtime() - t < d) __builtin_amdgcn_s_sleep(8); }
#undef IN
#undef BOTH
}

extern "C" void kernel_launch(void* const* d_in, const int* in_sizes, int n_in, void* d_out, int out_size, void* d_ws, size_t ws_size, hipStream_t stream) {
    static int grid = 0;
    if (grid == 0) {
        if (n_in != 30 || out_size != (int)O_END || ws_size < WS_END) { fprintf(stderr, "kernel_launch: unexpected problem (n_in %d, out %d, ws %zu); nothing launched\n", n_in, out_size, ws_size); grid = -1; return; }
        int dev = 0, cus = 0, per_cu = 0;
        if (hipGetDevice(&dev) != hipSuccess || hipDeviceGetAttribute(&cus, hipDeviceAttributeMultiprocessorCount, dev) != hipSuccess) { grid = -1; return; }
        if (hipFuncSetAttribute((const void*)hymba_fwd, hipFuncAttributeMaxDynamicSharedMemorySize, LDS_BYTES) != hipSuccess) { fprintf(stderr, "kernel_launch: hipFuncSetAttribute failed\n"); grid = -1; return; }
        if (hipOccupancyMaxActiveBlocksPerMultiprocessor(&per_cu, (const void*)hymba_fwd, NTHREADS, LDS_BYTES) != hipSuccess || per_cu < 1) fprintf(stderr, "kernel_launch: note: occupancy query reports %d\n", per_cu);
        (void)hipGetLastError();
        grid = cus;
        if (grid > 256) grid = 256;
    }
    if (grid < 0) return;
    if (hipMemsetAsync((char*)d_ws + WS_CTL, 0, CTL_ZERO_BYTES, stream) != hipSuccess) return;
    Args a{};
    for (int i = 0; i < 30; ++i) a.in[i] = (const float*)d_in[i];
    a.out = (float*)d_out; a.ws = (unsigned char*)d_ws;
#if MK_SPLIT
    for (int p = 0; p < N_PHASES; ++p) { a.ph_lo = p; a.ph_hi = p + 1; hipLaunchKernelGGL(hymba_fwd, dim3(grid), dim3(NTHREADS), LDS_BYTES, stream, a); }
#else
    a.ph_lo = 0; a.ph_hi = N_PHASES;
    hipLaunchKernelGGL(hymba_fwd, dim3(grid), dim3(NTHREADS), LDS_BYTES, stream, a);
#endif
}
```
